# Optimizing an MI355X kernel written in HIP

```python
import jax
import jax.numpy as jnp
from jax import lax
import numpy as np

D_MODEL = 1024
BATCH = 8
SEQ = 2048
DEPTH = 4

MLSTM_HEADS = 4
RET_HEADS = 4
HEAD_DIM = D_MODEL // (MLSTM_HEADS + RET_HEADS)
MLSTM_WIDTH = MLSTM_HEADS * HEAD_DIM
RET_WIDTH = RET_HEADS * HEAD_DIM
CHUNK = 128
QK_CONV = 4
ROPE_BASE = 10000.0
POOL_WINDOWS = (2, 4, 8, 16)
POOL_WIDTH = D_MODEL // 2
POOL_GROUP = POOL_WIDTH // len(POOL_WINDOWS)
CONV_WIDTH = D_MODEL - POOL_WIDTH
DW_KERNEL = 31
D_FF = -(-8 * D_MODEL // (3 * 256)) * 256
EPS = 1e-6
NEG = -1e30
EVEN_SIZES = (MLSTM_WIDTH,) * 4 + (MLSTM_HEADS,) * 2 + (RET_WIDTH,) * 4
EVEN_IN = sum(EVEN_SIZES)
ODD_IN = POOL_WIDTH + 2 * CONV_WIDTH

kernel_name = 'hybrid_mlstm_retention_pool_conv_trunk'


def rmsnorm(x, g):
    xf = x.astype(jnp.float32)
    y = xf * lax.rsqrt(jnp.mean(xf * xf, axis=-1, keepdims=True) + EPS)
    return (y * g.astype(jnp.float32)).astype(x.dtype)


def _normalize(xf):
    xc = xf - jnp.mean(xf, axis=-1, keepdims=True)
    return xc * lax.rsqrt(jnp.mean(xc * xc, axis=-1, keepdims=True) + EPS)


def head_norm(h, g):
    return _normalize(h.astype(jnp.float32)) * g.astype(jnp.float32)


def causal_dwconv(x, w, b):
    width, ch = w.shape
    y = lax.conv_general_dilated(
        x, w[:, None, :].astype(x.dtype), window_strides=(1,),
        padding=[(width - 1, 0)], dimension_numbers=('NWC', 'WIO', 'NWC'),
        feature_group_count=ch)
    return y + b.astype(x.dtype)


def rotary(t):
    S, D = t.shape[1], t.shape[-1]
    inv = ROPE_BASE ** (-jnp.arange(0, D, 2, dtype=jnp.float32) / D)
    ang = jnp.arange(S, dtype=jnp.float32)[:, None] * inv[None, :]
    cos = jnp.cos(ang)[None, :, None, :]
    sin = jnp.sin(ang)[None, :, None, :]
    tf = t.astype(jnp.float32)
    t1, t2 = tf[..., : D // 2], tf[..., D // 2:]
    return jnp.concatenate([t1 * cos - t2 * sin, t1 * sin + t2 * cos], axis=-1)


def _to_chunks(t):
    B, S, H = t.shape[:3]
    t = t.reshape((B, S // CHUNK, CHUNK, H) + t.shape[3:])
    return jnp.moveaxis(t, 3, 1)


def _from_chunks(t):
    B, H, NC, L, D = t.shape
    return jnp.moveaxis(t, 1, 3).reshape(B, NC * L, H, D)


def mlstm_chunkwise(q, k, v, i_pre, f_pre):
    d = q.shape[-1]
    q = _to_chunks(q.astype(jnp.float32))
    k = _to_chunks(k.astype(jnp.float32)) * (d ** -0.5)
    v = _to_chunks(v.astype(jnp.float32))
    ig = _to_chunks(i_pre)
    b = jnp.cumsum(jax.nn.log_sigmoid(_to_chunks(f_pre)), axis=-1)
    causal = jnp.tril(jnp.ones((CHUNK, CHUNK), dtype=bool))
    log_d = jnp.where(causal, b[..., :, None] - b[..., None, :] + ig[..., None, :], NEG)
    m_intra = jnp.max(log_d, axis=-1)
    w_end = b[..., -1:] - b + ig
    m_loc = jnp.max(w_end, axis=-1)
    a_end = jnp.exp(w_end - m_loc[..., None])
    kv_sum = jnp.einsum('bhcl,bhclk,bhclv->bhckv', a_end, k, v)
    n_sum = jnp.einsum('bhcl,bhclk->bhck', a_end, k)
    total = b[..., -1]

    def step(carry, inp):
        C, n, m = carry
        kv_c, n_c, m_c, tot_c = inp
        m_new = jnp.maximum(tot_c + m, m_c)
        s_old = jnp.exp(tot_c + m - m_new)
        s_new = jnp.exp(m_c - m_new)
        C_new = s_old[..., None, None] * C + s_new[..., None, None] * kv_c
        n_new = s_old[..., None] * n + s_new[..., None] * n_c
        return (C_new, n_new, m_new), (C, n, m)

    Bsz, H = q.shape[:2]
    init = (jnp.zeros((Bsz, H, d, d), jnp.float32),
            jnp.zeros((Bsz, H, d), jnp.float32),
            jnp.full((Bsz, H), NEG, jnp.float32))
    xs = tuple(jnp.moveaxis(t, 2, 0) for t in (kv_sum, n_sum, m_loc, total))
    _, (C_prev, n_prev, m_prev) = lax.scan(step, init, xs)
    C_prev = jnp.moveaxis(C_prev, 0, 2)
    n_prev = jnp.moveaxis(n_prev, 0, 2)
    m_prev = jnp.moveaxis(m_prev, 0, 2)

    log_inter = b + m_prev[..., None]
    m = jnp.maximum(m_intra, log_inter)
    s = jnp.einsum('bhcid,bhcjd->bhcij', q, k) * jnp.exp(log_d - m[..., None])
    inter = jnp.exp(log_inter - m)
    num = (jnp.einsum('bhcij,bhcjv->bhciv', s, v)
           + inter[..., None] * jnp.einsum('bhcik,bhckv->bhciv', q, C_prev))
    den = jnp.sum(s, axis=-1) + inter * jnp.einsum('bhcik,bhck->bhci', q, n_prev)
    h = num / jnp.maximum(jnp.abs(den), jnp.exp(-m))[..., None]
    return _from_chunks(h)


def retention_chunkwise(q, k, v):
    d = q.shape[-1]
    n_heads = q.shape[2]
    lg = jnp.log(1.0 - 2.0 ** (-5.0 - jnp.arange(n_heads, dtype=jnp.float32)))
    q = _to_chunks(q.astype(jnp.float32))
    k = _to_chunks(k.astype(jnp.float32)) * (d ** -0.5)
    v = _to_chunks(v.astype(jnp.float32))
    idx = jnp.arange(CHUNK, dtype=jnp.float32)
    rel = idx[:, None] - idx[None, :]
    decay = jnp.where(rel >= 0, jnp.exp(lg[:, None, None] * jnp.maximum(rel, 0.0)), 0.0)
    s = jnp.einsum('bhcid,bhcjd->bhcij', q, k) * decay[None, :, None]
    o = jnp.einsum('bhcij,bhcjv->bhciv', s, v)
    w_end = jnp.exp(lg[:, None] * (CHUNK - 1.0 - idx))
    kv_sum = jnp.einsum('hl,bhclk,bhclv->bhckv', w_end, k, v)
    chunk_decay = jnp.exp(lg * CHUNK)[None, :, None, None]

    def step(R, kv_c):
        return chunk_decay * R + kv_c, R

    init = jnp.zeros(kv_sum.shape[:2] + kv_sum.shape[3:], jnp.float32)
    _, R_prev = lax.scan(step, init, jnp.moveaxis(kv_sum, 2, 0))
    R_prev = jnp.moveaxis(R_prev, 0, 2)
    q_decay = jnp.exp(lg[:, None] * (idx + 1.0))[None, :, None, :, None]
    o = o + jnp.einsum('bhcik,bhckv->bhciv', q, R_prev) * q_decay
    return _from_chunks(o)


def even_mixer(h, w_in, qk_conv_w, qk_conv_b, i_bias, f_bias, mlstm_norm_g, ret_norm_g, w_out):
    Bsz, S, _ = h.shape
    z = h @ w_in
    offs = np.cumsum(EVEN_SIZES)[:-1].tolist()
    mq, mk, mv, mo, mi, mf, rq, rk, rv, rg = jnp.split(z, offs, axis=-1)
    qk = jax.nn.silu(causal_dwconv(jnp.concatenate([mq, mk], axis=-1), qk_conv_w, qk_conv_b))
    mq, mk = jnp.split(qk, 2, axis=-1)

    def heads(t, n):
        return t.reshape(Bsz, S, n, HEAD_DIM)

    i_pre = mi.astype(jnp.float32) + i_bias.astype(jnp.float32)
    f_pre = mf.astype(jnp.float32) + f_bias.astype(jnp.float32)
    h_m = mlstm_chunkwise(heads(mq, MLSTM_HEADS), heads(mk, MLSTM_HEADS),
                          heads(mv, MLSTM_HEADS), i_pre, f_pre)
    h_m = head_norm(jax.nn.sigmoid(heads(mo, MLSTM_HEADS).astype(jnp.float32)) * h_m, mlstm_norm_g)
    h_r = retention_chunkwise(rotary(heads(rq, RET_HEADS)), rotary(heads(rk, RET_HEADS)),
                              heads(rv, RET_HEADS))
    h_r = jax.nn.silu(heads(rg, RET_HEADS).astype(jnp.float32)) * head_norm(h_r, ret_norm_g)
    mixed = jnp.concatenate([h_m.reshape(Bsz, S, MLSTM_WIDTH),
                             h_r.reshape(Bsz, S, RET_WIDTH)], axis=-1).astype(h.dtype)
    return mixed @ w_out


def odd_mixer(h, w_in, pool_w, pool_scale, dw_w, dw_b, conv_norm_g, conv_norm_b, w_out):
    Bsz, S, _ = h.shape
    z = h @ w_in
    u, ga, gb = jnp.split(z, [POOL_WIDTH, POOL_WIDTH + CONV_WIDTH], axis=-1)
    uf = u.astype(jnp.float32).reshape(Bsz, S, len(POOL_WINDOWS), POOL_GROUP)
    csum = jnp.cumsum(uf, axis=1)
    count = jnp.arange(1, S + 1, dtype=jnp.float32)
    groups = []
    for g, w in enumerate(POOL_WINDOWS):
        cs = csum[:, :, g]
        prev = jnp.pad(cs, ((0, 0), (w, 0), (0, 0)))[:, :S]
        mean = (cs - prev) / jnp.minimum(count, float(w))[None, :, None]
        groups.append(mean - uf[:, :, g])
    pooled = jnp.stack(groups, axis=2).astype(h.dtype)
    y_pool = jnp.einsum('bsgi,gio->bsgo', pooled, pool_w).reshape(Bsz, S, POOL_WIDTH) * pool_scale
    y = ga * jax.nn.sigmoid(gb)
    y = causal_dwconv(y, dw_w, dw_b)
    yf = _normalize(y.astype(jnp.float32)) * conv_norm_g + conv_norm_b
    y_conv = jax.nn.silu(yf).astype(h.dtype)
    mixed = jnp.concatenate([y_pool.astype(h.dtype), y_conv], axis=-1)
    return mixed @ w_out


def swiglu(h, w_gate, w_up, w_down):
    return (jax.nn.silu(h @ w_gate) * (h @ w_up)) @ w_down


def setup_inputs(seed: int = 0) -> dict:
    key = jax.random.key(seed)
    ks = jax.random.split(key, 24)
    n_even = (DEPTH + 1) // 2
    n_odd = DEPTH // 2

    def nrm(k, shape, scale):
        return jax.random.normal(k, shape, jnp.float32) * scale

    return {
        'x': nrm(ks[0], (BATCH, SEQ, D_MODEL), 1.0),
        'norm_mix_g': 1.0 + nrm(ks[1], (DEPTH, D_MODEL), 0.02),
        'norm_ffn_g': 1.0 + nrm(ks[2], (DEPTH, D_MODEL), 0.02),
        'final_norm_g': 1.0 + nrm(ks[3], (D_MODEL,), 0.02),
        'ev_w_in': nrm(ks[4], (n_even, D_MODEL, EVEN_IN), D_MODEL ** -0.5),
        'ev_qk_conv_w': nrm(ks[5], (n_even, QK_CONV, 2 * MLSTM_WIDTH), QK_CONV ** -0.5),
        'ev_qk_conv_b': nrm(ks[6], (n_even, 2 * MLSTM_WIDTH), 0.02),
        'ev_i_bias': nrm(ks[7], (n_even, MLSTM_HEADS), 0.1),
        'ev_f_bias': jnp.linspace(3.0, 6.0, MLSTM_HEADS, dtype=jnp.float32)[None, :]
                     + nrm(ks[8], (n_even, MLSTM_HEADS), 0.1),
        'ev_mlstm_norm_g': 1.0 + nrm(ks[9], (n_even, MLSTM_HEADS, HEAD_DIM), 0.02),
        'ev_ret_norm_g': 1.0 + nrm(ks[10], (n_even, RET_HEADS, HEAD_DIM), 0.02),
        'ev_w_out': nrm(ks[11], (n_even, MLSTM_WIDTH + RET_WIDTH, D_MODEL), (MLSTM_WIDTH + RET_WIDTH) ** -0.5),
        'od_w_in': nrm(ks[12], (n_odd, D_MODEL, ODD_IN), D_MODEL ** -0.5),
        'od_pool_w': nrm(ks[13], (n_odd, len(POOL_WINDOWS), POOL_GROUP, POOL_GROUP), POOL_GROUP ** -0.5),
        'od_pool_scale': 1.0 + nrm(ks[14], (n_odd, POOL_WIDTH), 0.1),
        'od_dw_w': nrm(ks[15], (n_odd, DW_KERNEL, CONV_WIDTH), DW_KERNEL ** -0.5),
        'od_dw_b': nrm(ks[16], (n_odd, CONV_WIDTH), 0.02),
        'od_conv_norm_g': 1.0 + nrm(ks[17], (n_odd, CONV_WIDTH), 0.02),
        'od_conv_norm_b': nrm(ks[18], (n_odd, CONV_WIDTH), 0.02),
        'od_w_out': nrm(ks[19], (n_odd, POOL_WIDTH + CONV_WIDTH, D_MODEL), (POOL_WIDTH + CONV_WIDTH) ** -0.5),
        'ffn_w_gate': nrm(ks[20], (DEPTH, D_MODEL, D_FF), D_MODEL ** -0.5),
        'ffn_w_up': nrm(ks[21], (DEPTH, D_MODEL, D_FF), D_MODEL ** -0.5),
        'ffn_w_down': nrm(ks[22], (DEPTH, D_FF, D_MODEL), D_FF ** -0.5),
    }


def reference(x, norm_mix_g, norm_ffn_g, final_norm_g, ev_w_in, ev_qk_conv_w, ev_qk_conv_b,
              ev_i_bias, ev_f_bias, ev_mlstm_norm_g, ev_ret_norm_g, ev_w_out, od_w_in,
              od_pool_w, od_pool_scale, od_dw_w, od_dw_b, od_conv_norm_g, od_conv_norm_b,
              od_w_out, ffn_w_gate, ffn_w_up, ffn_w_down):
    for layer in range(DEPTH):
        j = layer // 2
        h = rmsnorm(x, norm_mix_g[layer])
        if layer % 2 == 0:
            y = even_mixer(h, ev_w_in[j], ev_qk_conv_w[j], ev_qk_conv_b[j], ev_i_bias[j],
                           ev_f_bias[j], ev_mlstm_norm_g[j], ev_ret_norm_g[j], ev_w_out[j])
        else:
            y = odd_mixer(h, od_w_in[j], od_pool_w[j], od_pool_scale[j], od_dw_w[j], od_dw_b[j],
                          od_conv_norm_g[j], od_conv_norm_b[j], od_w_out[j])
        x = x + y.astype(x.dtype)
        h = rmsnorm(x, norm_ffn_g[layer])
        x = x + swiglu(h, ffn_w_gate[layer], ffn_w_up[layer], ffn_w_down[layer]).astype(x.dtype)
    return rmsnorm(x, final_norm_g)
```

```cpp
#include <hip/hip_runtime.h>
#include <cstdio>
#include <cstdint>
#include <cmath>

namespace pg8 {
#define PG8_LAS __attribute__((address_space(3)))
typedef unsigned short bf16_t;
typedef short bf16x8 __attribute__((ext_vector_type(8)));
typedef float f32x4 __attribute__((ext_vector_type(4)));
typedef unsigned u32x4 __attribute__((ext_vector_type(4)));
constexpr int BM = 256, BK = 64, HALF = 128, HTB = HALF * BK * 2  , STAGE_BYTES = 8 * HTB, NXCD = 8, WGM = 8;

__host__ __device__ __forceinline__ int lds_byte(int r, int c) { const int st = (r >> 4) * 2 + (c >> 5), rr = r & 15, cc = c & 31, ob = rr * 64 + cc * 2; return st * 1024 + (ob ^ (((ob >> 9) & 1) << 5)); }
__host__ __device__ __forceinline__ void stage_rc(int b, int& R, int& C) { const int st = b / 1024, sb = b % 1024, swz = sb ^ (((sb >> 9) & 1) << 5); R = (st >> 1) * 16 + swz / 64; C = (st & 1) * 32 + (swz % 64) / 2; }
__host__ __device__ __forceinline__ int perm32(int rho) { const int n = rho >> 4, i = rho & 15; return 8 * (i >> 2) + 4 * n + (i & 3); }

struct Unit { int pm, pn; };
struct Gemm { const bf16_t* A; const bf16_t* Bt; int M, N, K; };

struct StaticOrder {
    int nM, nN, nwg, G, c;
    __host__ __device__ void init(int M, int N, int G_, int c_) { nM = M / BM; nN = N / BM; nwg = nM * nN; G = G_; c = c_; }
    __host__ __device__ bool next(int i, Unit& u) const {
        const long L = (long)i * G + c; if (L >= nwg) return false;
        int wgid = (int)L; { const int q = nwg / NXCD, r = nwg % NXCD, xcd = wgid % NXCD, off = wgid / NXCD; wgid = (xcd < r ? xcd * (q + 1) : r * (q + 1) + (xcd - r) * q) + off; }
        const int nig = WGM * nN, gid = wgid / nig, fm = gid * WGM, gsz = (nM - fm) < WGM ? (nM - fm) : WGM;
        u.pm = fm + ((wgid % nig) % gsz); u.pn = (wgid % nig) / gsz; return true;
    }
    __device__ __forceinline__ void a_ready(const Unit&) const {}
    __device__ __forceinline__ void done(const Unit&) const {}
};


__device__ __forceinline__ unsigned cvt_pk_bf16(float lo, float hi) { unsigned r; asm volatile("v_cvt_pk_bf16_f32 %0, %1, %2" : "=v"(r) : "v"(lo), "v"(hi)); return r; }
typedef float f32x2 __attribute__((ext_vector_type(2)));

typedef float f32x2 __attribute__((ext_vector_type(2)));
typedef unsigned u32x2 __attribute__((ext_vector_type(2)));
constexpr float RMS_EPS = 1e-6f;
__device__ __forceinline__ float row_rstd(const float* ssq, int row, int fq) {
    const f32x4 p = *(const f32x4*)(ssq + (size_t)row * 16 + 4 * fq);
    float s = (p[0] + p[1]) + (p[2] + p[3]);
    s += __shfl_xor(s, 16); s += __shfl_xor(s, 32);
    return __builtin_amdgcn_rsqf(s * (1.0f / 1024.0f) + RMS_EPS);
}
struct EpiZ {
    static constexpr bool PERM = true, AFTER_DRAIN = false;
    bf16_t* O; int ldc; const float* ssq;
    __device__ __forceinline__ void operator()(const f32x4 (&acc)[2][2][4][2], const Unit& u, int wr, int wc, int fr, int fq) const {
        const int row0 = u.pm * BM + wr * 64 + fr, col0 = u.pn * BM + wc * 32 + 8 * fq;
#pragma unroll
        for (int ai = 0; ai < 2; ++ai)
#pragma unroll
            for (int m = 0; m < 4; ++m) { const int row = row0 + ai * HALF + m * 16; const float rs = row_rstd(ssq, row, fq);
                bf16_t* rowp = O + (size_t)row * ldc + col0;
#pragma unroll
                for (int bj = 0; bj < 2; ++bj) { const f32x4 v0 = acc[ai][bj][m][0] * rs, v1 = acc[ai][bj][m][1] * rs;
                    u32x4 w; w.x = cvt_pk_bf16(v0[0], v0[1]); w.y = cvt_pk_bf16(v0[2], v0[3]); w.z = cvt_pk_bf16(v1[0], v1[1]); w.w = cvt_pk_bf16(v1[2], v1[3]);
                    *(u32x4*)(rowp + bj * HALF) = w; } }
    }
};
struct EpiSwiGLU {
    static constexpr bool PERM = true, AFTER_DRAIN = false;
    bf16_t* O; int ldc; const float* ssq;
    __device__ __forceinline__ void operator()(const f32x4 (&acc)[2][2][4][2], const Unit& u, int wr, int wc, int fr, int fq) const {
        const int row0 = u.pm * BM + wr * 64 + fr, col0 = u.pn * HALF + wc * 32 + 8 * fq;
#pragma unroll
        for (int ai = 0; ai < 2; ++ai)
#pragma unroll
            for (int m = 0; m < 4; ++m) { const int row = row0 + ai * HALF + m * 16; const float rs = row_rstd(ssq, row, fq);
                float o[8];
#pragma unroll
                for (int n = 0; n < 2; ++n)
#pragma unroll
                    for (int e = 0; e < 4; ++e) { const float g = acc[ai][0][m][n][e] * rs, up = acc[ai][1][m][n][e] * rs;
                        const float sg = g * __builtin_amdgcn_rcpf(1.0f + __builtin_amdgcn_exp2f(-1.4426950408889634f * g)); o[4 * n + e] = sg * up; }
                u32x4 w; w.x = cvt_pk_bf16(o[0], o[1]); w.y = cvt_pk_bf16(o[2], o[3]); w.z = cvt_pk_bf16(o[4], o[5]); w.w = cvt_pk_bf16(o[6], o[7]);
                *(u32x4*)(O + (size_t)row * ldc + col0) = w; }
    }
};
struct EpiRes {
    static constexpr bool PERM = false, AFTER_DRAIN = false;
    const float* base; float* out; bf16_t* xb; float* ssq; int ldc;
    __device__ __forceinline__ void operator()(const f32x4 (&acc)[2][2][4][2], const Unit& u, int wr, int wc, int fr, int fq) const {
        const int row0 = u.pm * BM + wr * 64 + fr, col0 = u.pn * BM + wc * 32 + 4 * fq;
#pragma unroll
        for (int ai = 0; ai < 2; ++ai)
#pragma unroll
            for (int m = 0; m < 4; ++m) { const int row = row0 + ai * HALF + m * 16; const size_t off = (size_t)row * ldc + col0; float q = 0.f;
#pragma unroll
                for (int bj = 0; bj < 2; ++bj)
#pragma unroll
                    for (int n = 0; n < 2; ++n) { const size_t o2 = off + bj * HALF + n * 16; const f32x4 xn = *(const f32x4*)(base + o2) + acc[ai][bj][m][n];
                        *(f32x4*)(out + o2) = xn; u32x2 w; w.x = cvt_pk_bf16(xn[0], xn[1]); w.y = cvt_pk_bf16(xn[2], xn[3]); *(u32x2*)(xb + o2) = w;
                        q += (xn[0] * xn[0] + xn[1] * xn[1]) + (xn[2] * xn[2] + xn[3] * xn[3]); }
                q += __shfl_xor(q, 16); q += __shfl_xor(q, 32);
                if (fq == 0) ssq[(size_t)row * 16 + u.pn * 4 + wc] = q;
                asm volatile("" ::: "memory"); }
    }
};


template <class Epi, class Sched, bool ALIGN_EPI = false, bool SP2 = false>
__device__ __forceinline__ void gemm_phase(PG8_LAS unsigned char* lds, const Gemm g, const Sched& S, const Epi& E) {
    int tid_ = threadIdx.x; asm volatile("" : "+v"(tid_));
    const int tid = tid_, wid = __builtin_amdgcn_readfirstlane(tid >> 6), lane = tid & 63, wr = wid >> 2, wc = wid & 3, fr = lane & 15, fq = lane >> 4;
    const int K = g.K, nt = K / BK;
    unsigned voffA[2], voffB[2];
#pragma unroll
    for (int i = 0; i < 2; ++i) { int R, C; stage_rc(tid * 16 + i * 8192, R, C); const int Rb = Epi::PERM ? ((R & ~31) + perm32(R & 31)) : R;
        voffA[i] = (unsigned)(R * K + C) * 2u; voffB[i] = (unsigned)(Rb * K + C) * 2u; }
    const size_t kstep = (size_t)(BK * 2);
    const size_t hstep = (size_t)HALF * K * 2;
    const size_t tstep = 2 * hstep;
    const unsigned ldsw = (unsigned)wid * 1024u;
    const int aoff = lds_byte(wr * 64 + fr, fq * 8), boff = lds_byte(wc * 32 + fr, fq * 8);
#define PG8_SA(b, h) (((b) * 2 + (h)) * HTB)
#define PG8_SB(b, h) ((4 + (b) * 2 + (h)) * HTB)
#define PG8_STAGE(bufoff, gbase, voff) do { _Pragma("unroll") for (int _i = 0; _i < 2; ++_i) \
        __builtin_amdgcn_global_load_lds((const unsigned*)((const char*)(gbase) + (voff)[_i]), (PG8_LAS unsigned*)(lds + (bufoff) + ldsw + _i * 8192), 16, 0, 0); } while (0)
#define PG8_LDA(dst, b, h) do { _Pragma("unroll") for (int m = 0; m < 4; ++m) _Pragma("unroll") for (int k = 0; k < 2; ++k) dst[m][k] = *(const PG8_LAS bf16x8*)(lds + PG8_SA(b, h) + aoff + m * 2048 + k * 1024); } while (0)
#define PG8_LDB(dst, b, h) do { _Pragma("unroll") for (int n = 0; n < 2; ++n) _Pragma("unroll") for (int k = 0; k < 2; ++k) dst[n][k] = *(const PG8_LAS bf16x8*)(lds + PG8_SB(b, h) + boff + n * 2048 + k * 1024); } while (0)
#define PG8_MMA(ai, bj, At, Bt) do { __builtin_amdgcn_s_setprio(1); _Pragma("unroll") for (int m = 0; m < 4; ++m) _Pragma("unroll") for (int n = 0; n < 2; ++n) _Pragma("unroll") for (int k = 0; k < 2; ++k) \
        acc[ai][bj][m][n] = __builtin_amdgcn_mfma_f32_16x16x32_bf16(Bt[n][k], At[m][k], acc[ai][bj][m][n], 0, 0, 0); __builtin_amdgcn_s_setprio(0); } while (0)
#define PG8_WAIT_V(n) asm volatile("s_waitcnt vmcnt(" #n ")" ::: "memory")
#define PG8_WAIT_L(n) asm volatile("s_waitcnt lgkmcnt(" #n ")" ::: "memory")
#define PG8_BAR __builtin_amdgcn_s_barrier()
#define PG8_SCHED __builtin_amdgcn_sched_barrier(0)
    Unit cur, nxt; int ui = 0;
    if (!S.next(0, cur)) return;
    f32x4 acc[2][2][4][2];
#pragma unroll
    for (int a = 0; a < 2; ++a)
#pragma unroll
        for (int b = 0; b < 2; ++b)
#pragma unroll
            for (int m = 0; m < 4; ++m)
#pragma unroll
                for (int n = 0; n < 2; ++n) acc[a][b][m][n] = (f32x4){0.f, 0.f, 0.f, 0.f};
    bf16x8 At[4][2], B0[2][2], B1[2][2];
    const char* cA = (const char*)g.A + (size_t)cur.pm * tstep; const char* cB = (const char*)g.Bt + (size_t)cur.pn * tstep;
    S.a_ready(cur);
    if constexpr (SP2) {
        PG8_STAGE(PG8_SB(0, 0), cB, voffB); PG8_STAGE(PG8_SB(0, 1), cB + hstep, voffB); PG8_STAGE(PG8_SA(0, 0), cA, voffA); PG8_STAGE(PG8_SA(0, 1), cA + hstep, voffA);
        if (wr == 1) PG8_BAR;
        PG8_WAIT_V(2); PG8_BAR;
        PG8_STAGE(PG8_SB(1, 0), cB + kstep, voffB); PG8_STAGE(PG8_SA(1, 0), cA + kstep, voffA); PG8_STAGE(PG8_SB(1, 1), cB + hstep + kstep, voffB);
        PG8_WAIT_V(6); PG8_BAR;
    } else {
        PG8_STAGE(PG8_SB(0, 0), cB, voffB); PG8_STAGE(PG8_SA(0, 0), cA, voffA); PG8_STAGE(PG8_SB(0, 1), cB + hstep, voffB); PG8_STAGE(PG8_SA(0, 1), cA + hstep, voffA);
        if (wr == 1) PG8_BAR;
        PG8_WAIT_V(4); PG8_BAR;
        PG8_STAGE(PG8_SB(1, 0), cB + kstep, voffB); PG8_STAGE(PG8_SA(1, 0), cA + kstep, voffA); PG8_STAGE(PG8_SB(1, 1), cB + hstep + kstep, voffB);
        PG8_WAIT_V(6); PG8_BAR;
    }
    for (;;) {
        const bool has_next = S.next(ui + 1, nxt);
        const char* nA = has_next ? (const char*)g.A + (size_t)nxt.pm * tstep : cA; const char* nB = has_next ? (const char*)g.Bt + (size_t)nxt.pn * tstep : cB;
        for (int t = 0; t < nt; t += 2) {
            const bool last = (t == nt - 2);
            const char* a1 = cA + (size_t)(t + 1) * kstep;
            const char* a2 = last ? nA : cA + (size_t)(t + 2) * kstep; const char* b2 = last ? nB : cB + (size_t)(t + 2) * kstep;
            const char* a3 = a2 + kstep; const char* b3 = b2 + kstep;
            if (last && has_next) S.a_ready(nxt);
            if constexpr (SP2) {
            PG8_LDB(B0, 0, 0); PG8_LDB(B1, 0, 1); PG8_SCHED; PG8_LDA(At, 0, 0); PG8_STAGE(PG8_SA(1, 1), a1 + hstep, voffA);
            PG8_WAIT_V(8); PG8_WAIT_L(0); PG8_BAR; PG8_MMA(0, 0, At, B0); PG8_MMA(0, 1, At, B1); PG8_BAR; PG8_SCHED;
            PG8_LDA(At, 0, 1); PG8_STAGE(PG8_SB(0, 0), b2, voffB); PG8_STAGE(PG8_SB(0, 1), b2 + hstep, voffB); PG8_STAGE(PG8_SA(0, 0), a2, voffA);
            PG8_WAIT_V(8); PG8_WAIT_L(0); PG8_BAR; PG8_MMA(1, 0, At, B0); PG8_MMA(1, 1, At, B1); PG8_BAR; PG8_SCHED;
            PG8_LDB(B0, 1, 0); PG8_LDB(B1, 1, 1); PG8_SCHED; PG8_LDA(At, 1, 0); PG8_STAGE(PG8_SA(0, 1), a2 + hstep, voffA);
            PG8_WAIT_V(8); PG8_WAIT_L(0); PG8_BAR; PG8_MMA(0, 0, At, B0); PG8_MMA(0, 1, At, B1); PG8_BAR; PG8_SCHED;
            PG8_LDA(At, 1, 1); PG8_STAGE(PG8_SB(1, 0), b3, voffB); PG8_STAGE(PG8_SB(1, 1), b3 + hstep, voffB); PG8_STAGE(PG8_SA(1, 0), a3, voffA);
            PG8_WAIT_V(8); PG8_WAIT_L(0); PG8_BAR; PG8_MMA(1, 0, At, B0); PG8_MMA(1, 1, At, B1); PG8_BAR; PG8_SCHED;
            } else {
            PG8_LDB(B0, 0, 0); PG8_SCHED; PG8_LDA(At, 0, 0); PG8_STAGE(PG8_SA(1, 1), a1 + hstep, voffA);
            PG8_WAIT_L(8); PG8_BAR; PG8_WAIT_L(0); PG8_MMA(0, 0, At, B0); PG8_BAR; PG8_SCHED;
            PG8_LDB(B1, 0, 1); PG8_STAGE(PG8_SB(0, 0), b2, voffB);
            PG8_BAR; PG8_WAIT_L(0); PG8_MMA(0, 1, At, B1); PG8_BAR;
            PG8_LDA(At, 0, 1); PG8_STAGE(PG8_SA(0, 0), a2, voffA);
            PG8_BAR; PG8_WAIT_L(0); PG8_MMA(1, 0, At, B0); PG8_BAR; PG8_SCHED;
            PG8_STAGE(PG8_SB(0, 1), b2 + hstep, voffB);
            PG8_WAIT_V(6); PG8_BAR; PG8_MMA(1, 1, At, B1); PG8_BAR;
            PG8_LDB(B0, 1, 0); PG8_SCHED; PG8_LDA(At, 1, 0); PG8_STAGE(PG8_SA(0, 1), a2 + hstep, voffA);
            PG8_WAIT_L(8); PG8_BAR; PG8_WAIT_L(0); PG8_MMA(0, 0, At, B0); PG8_BAR; PG8_SCHED;
            PG8_LDB(B1, 1, 1); PG8_STAGE(PG8_SB(1, 0), b3, voffB);
            PG8_BAR; PG8_WAIT_L(0); PG8_MMA(0, 1, At, B1); PG8_BAR;
            PG8_LDA(At, 1, 1); PG8_STAGE(PG8_SA(1, 0), a3, voffA);
            PG8_BAR; PG8_WAIT_L(0); PG8_MMA(1, 0, At, B0); PG8_BAR; PG8_SCHED;
            PG8_STAGE(PG8_SB(1, 1), b3 + hstep, voffB);
            PG8_WAIT_V(6); PG8_BAR; PG8_MMA(1, 1, At, B1); PG8_BAR;
            }
        }
        if constexpr (ALIGN_EPI) { if (wr == 0) PG8_BAR; }
        if constexpr (!Epi::AFTER_DRAIN) { E(acc, cur, wr, wc, fr, fq); S.done(cur); }
        if (!has_next) break;
#pragma unroll
        for (int a = 0; a < 2; ++a)
#pragma unroll
            for (int b = 0; b < 2; ++b)
#pragma unroll
                for (int m = 0; m < 4; ++m)
#pragma unroll
                    for (int n = 0; n < 2; ++n) acc[a][b][m][n] = (f32x4){0.f, 0.f, 0.f, 0.f};
        cur = nxt; cA = nA; cB = nB; ++ui;
        if constexpr (ALIGN_EPI) { if (wr == 1) PG8_BAR; }
    }
    PG8_WAIT_V(0);
    if constexpr (!ALIGN_EPI) { if (wr == 0) PG8_BAR; }
    PG8_BAR;
    if constexpr (Epi::AFTER_DRAIN) { E.fused(acc, cur, wr, wc, fr, fq, lds, wid, lane); S.done(cur); }
#undef PG8_SA
#undef PG8_SB
#undef PG8_STAGE
#undef PG8_LDA
#undef PG8_LDB
#undef PG8_MMA
#undef PG8_WAIT_V
#undef PG8_WAIT_L
#undef PG8_BAR
#undef PG8_SCHED
}
}


constexpr int NWAVES = 8;
constexpr int BATCH = 8, SEQ = 2048, D = 1024, M = BATCH * SEQ, DEPTH = 4, DFF = 2816, NGU = 2 * DFF;
constexpr int EV_N = 4096, EV_IN = 4104, OD_N = 1536, HD = 128, CHUNK = 128;
constexpr float EPS = 1e-6f;
constexpr float KSCALE = 0.08838834764831845f;
constexpr size_t MiB = 1u << 20;
constexpr size_t WS_CTL = 0, CTL_ZERO_BYTES = 65536;
constexpr size_t WS_ROT = 1 * MiB;
constexpr size_t WS_GATES = 2 * MiB;
constexpr size_t WS_WTG = 2 * MiB + 512 * 1024;
constexpr size_t WS_WTP = WS_WTG + 65536;
constexpr size_t WS_SSQ = 3 * MiB;
constexpr size_t WS_WIN = 4 * MiB;
constexpr size_t WS_WOUT = 12 * MiB;
constexpr size_t WS_WGU = 14 * MiB;
constexpr size_t WS_WD = 25 * MiB;
constexpr size_t WS_XB = 32 * MiB;
constexpr size_t WS_MIXED = 64 * MiB;
constexpr size_t WS_Z = 96 * MiB;
constexpr size_t WS_END = 224 * MiB;
constexpr int CW_TMO = 0, CW_CODE = 1, CW_BAR = 4096;
constexpr int RING_OFF = 0, RING_BYTES = 131072;
constexpr int LDSCTL_OFF = RING_BYTES, MISC_OFF = LDSCTL_OFF + 320;
constexpr int LDS_BYTES = 147456;


#define GAS __attribute__((address_space(1)))
#define LAS __attribute__((address_space(3)))
typedef unsigned short bf16;
typedef unsigned v4u __attribute__((ext_vector_type(4)));
typedef float f32x4 __attribute__((ext_vector_type(4)));
typedef short bf16x8 __attribute__((ext_vector_type(8)));
typedef GAS unsigned gu32;
typedef GAS unsigned long long gu64;
#define RLX_AGENT __ATOMIC_RELAXED, __HIP_MEMORY_SCOPE_AGENT
#define LDS_WAIT() asm volatile("s_waitcnt lgkmcnt(0)" ::: "memory")
#define VM_WAIT() asm volatile("s_waitcnt vmcnt(0)" ::: "memory")
__device__ __forceinline__ unsigned long long rt() { return __builtin_amdgcn_s_memrealtime(); }
__device__ __forceinline__ unsigned f2bf(float f) { unsigned u = __builtin_bit_cast(unsigned, f); return (u + 0x7fffu + ((u >> 16) & 1u)) >> 16; }
__device__ __forceinline__ unsigned pk2(float lo, float hi) { return f2bf(lo) | (f2bf(hi) << 16); }

#define XB_TMO      128
#define XB_XCNT(j)  (256  + 64 * (j))
#define XB_XSUB(j)  (1280 + 64 * (j))
#define XB_XGEN(j)  (2304 + 64 * (j))
#define XB_TOP      3328
#define XB_TOPGEN   3392
#define XCD_BAR_WORDS 3456
#define XB_SPIN_CAP (1u << 18)

__device__ __forceinline__ unsigned xb_ld(unsigned* p)              { return __hip_atomic_load(p, __ATOMIC_RELAXED, __HIP_MEMORY_SCOPE_AGENT); }
__device__ __forceinline__ unsigned xb_add(unsigned* p, unsigned v) { return __hip_atomic_fetch_add(p, v, __ATOMIC_RELAXED, __HIP_MEMORY_SCOPE_AGENT); }
__device__ __forceinline__ unsigned xb_xcc_id() { return (unsigned)__builtin_amdgcn_s_getreg((3 << 11) | 20) & 0xFu; }
#define XB_SPIN(cond, bar) do { unsigned _sp = 0; while (cond) { __builtin_amdgcn_s_sleep(1); \
    if ((++_sp & 255u) == 0u) { if (xb_ld(&(bar)[XB_TMO])) break; if (_sp > XB_SPIN_CAP) { atomicAdd(&(bar)[XB_TMO], 1u); break; } } } } while (0)

struct XcdBarrier {
    unsigned* bar; unsigned x;
    volatile LAS unsigned* st;
};

__device__ __forceinline__ XcdBarrier xcd_barrier_post(unsigned* bar, volatile LAS unsigned* st) {
    XcdBarrier b; b.bar = bar; b.x = xb_xcc_id(); b.st = st;
    if (threadIdx.x == 0) (void)xb_add(&bar[XB_XCNT(b.x)], 1u);
    return b;
}
__device__ __forceinline__ void xcd_barrier_complete(unsigned* bar, unsigned x, unsigned& nloc, unsigned& nx) {
    const unsigned G = gridDim.x * gridDim.y * gridDim.z;
    unsigned sum, cnt, mine, sp = 0u;
    for (;;) {
        sum = 0u; cnt = 0u; mine = 0u;
#pragma unroll
        for (unsigned j = 0; j < 16; ++j) { const unsigned c = xb_ld(&bar[XB_XCNT(j)]); sum += c; cnt += (c > 0u) ? 1u : 0u; mine = (j == x) ? c : mine; }
        if (sum == G) break;
        __builtin_amdgcn_s_sleep(1);
        if ((++sp & 255u) == 0u) { if (xb_ld(&bar[XB_TMO])) break; if (sp > XB_SPIN_CAP) { atomicAdd(&bar[XB_TMO], 1u); break; } }
    }
    nloc = mine > 0u ? mine : 1u; nx = cnt > 0u ? cnt : 1u;
}

__device__ __forceinline__ void xcd_barrier(const XcdBarrier& b) {
    asm volatile("s_waitcnt vmcnt(0)" ::: "memory");
    __syncthreads();
    if (threadIdx.x == 0) {
        unsigned* bar = b.bar;
        __builtin_amdgcn_s_waitcnt(0);
        unsigned nloc = b.st[0], nx = b.st[1];
        if (nloc == 0u) { xcd_barrier_complete(bar, b.x, nloc, nx); b.st[0] = nloc; b.st[1] = nx; }
        const unsigned old = xb_add(&bar[XB_XSUB(b.x)], 1u);
        const unsigned gen = old / nloc;
        if (old + 1u == (gen + 1u) * nloc) {
            __builtin_amdgcn_fence(__ATOMIC_RELEASE, "agent");
            asm volatile("s_waitcnt vmcnt(0)" ::: "memory");
            const unsigned og = xb_add(&bar[XB_TOP], 1u);
            const unsigned tg = og / nx;
            if (og + 1u == (tg + 1u) * nx) xb_add(&bar[XB_TOPGEN], 1u);
            else XB_SPIN(xb_ld(&bar[XB_TOPGEN]) == tg, bar);
            __builtin_amdgcn_fence(__ATOMIC_ACQUIRE, "agent");
            xb_add(&bar[XB_XGEN(b.x)], 1u);
            asm volatile("s_waitcnt vmcnt(0)" ::: "memory");
        } else {
            XB_SPIN(xb_ld(&bar[XB_XGEN(b.x)]) == gen, bar);
            __builtin_amdgcn_fence(__ATOMIC_ACQUIRE, "agent");
            asm volatile("s_waitcnt vmcnt(0)" ::: "memory");
        }
    }
    __syncthreads();
}


__device__ __forceinline__ float bf2f(bf16 u) { return __builtin_bit_cast(float, (unsigned)u << 16); }
__device__ __forceinline__ float wave_sum(float v) {
#pragma unroll
    for (int o = 1; o < 64; o <<= 1) v += __shfl_xor(v, o);
    return v;
}
__device__ __forceinline__ float sigmoidf_(float x) { return 1.0f / (1.0f + __expf(-x)); }
__device__ __forceinline__ float block_sum(float v, LAS float* buf, int wave, int lane) {
    v = wave_sum(v); if (lane == 0) buf[wave] = v; __syncthreads();
    float s = 0.f;
#pragma unroll
    for (int i = 0; i < NWAVES; ++i) s += buf[i];
    __syncthreads(); return s;
}

__device__ __forceinline__ void tr_item(const float* W, int ldw, int c0, const float* gs, bf16* WT, int ldk, int drow, LAS float* scr, int k0, int n0, int lane) {
#pragma unroll 8
    for (int i = 0; i < 32; ++i) { const int kk = 2 * i + (lane >> 5); float w = W[(size_t)(k0 + kk) * ldw + c0 + n0 + (lane & 31)]; if (gs) w *= gs[k0 + kk]; scr[kk * 33 + (lane & 31)] = w; }
    LDS_WAIT(); asm volatile("" ::: "memory");
    const int c = lane & 7;
#pragma unroll
    for (int j = 0; j < 4; ++j) { const int n = (lane >> 3) + 8 * j; const LAS float* s = scr + (8 * c) * 33 + n;
        v4u o; o.x = pk2(s[0 * 33], s[1 * 33]); o.y = pk2(s[2 * 33], s[3 * 33]); o.z = pk2(s[4 * 33], s[5 * 33]); o.w = pk2(s[6 * 33], s[7 * 33]);
        *(GAS v4u*)(WT + (size_t)(drow + n0 + n) * ldk + k0 + 8 * c) = o; }
    LDS_WAIT(); asm volatile("" ::: "memory");
}
typedef const __attribute__((address_space(4))) char* kaptr_t;
__device__ __forceinline__ kaptr_t karg() { kaptr_t p = (kaptr_t)__builtin_amdgcn_kernarg_segment_ptr(); asm volatile("" : "+s"(p)); return p; }
struct Ptrs {
    __device__ __forceinline__ const float* in(int k) const { return *(const float* const __attribute__((address_space(4)))*)(karg() + 8 * k); }
#define PF(name, k) __device__ __forceinline__ const float* name() const { return in(k); }
    PF(x, 0) PF(g_mix, 1) PF(g_ffn, 2) PF(g_fin, 3) PF(ev_w_in, 4) PF(ev_cw, 5) PF(ev_cb, 6) PF(ev_ib, 7) PF(ev_fb, 8) PF(ev_ngm, 9) PF(ev_ngr, 10) PF(ev_w_out, 11)
    PF(od_w_in, 12) PF(od_pw, 13) PF(od_ps, 14) PF(od_dw, 15) PF(od_db, 16) PF(od_ng, 17) PF(od_nb, 18) PF(od_w_out, 19) PF(w_gate, 20) PF(w_up, 21) PF(w_down, 22)
#undef PF
    __device__ __forceinline__ float* out() const { return *(float* const __attribute__((address_space(4)))*)(karg() + 184); }
    __device__ __forceinline__ unsigned char* ws() const { return *(unsigned char* const __attribute__((address_space(4)))*)(karg() + 192); }
    __device__ __forceinline__ int ph_lo() const { return *(const __attribute__((address_space(4))) int*)(karg() + 200); }
    __device__ __forceinline__ int ph_hi() const { return *(const __attribute__((address_space(4))) int*)(karg() + 204); }
};
__device__ __forceinline__ void convert_layer(const Ptrs& P, int L, LAS unsigned char* lds, int gw, int NGW, int wave, int lane) {
    LAS float* scr = (LAS float*)(lds + RING_OFF + wave * 16384);
    const int j = L >> 1; const bool even = (L & 1) == 0;
    bf16* WIN = (bf16*)(P.ws() + WS_WIN); bf16* WOUT = (bf16*)(P.ws() + WS_WOUT); bf16* WGU = (bf16*)(P.ws() + WS_WGU); bf16* WD = (bf16*)(P.ws() + WS_WD);
    const float* gm = P.g_mix() + L * D; const float* gf = P.g_ffn() + L * D;
    const float* Win = even ? P.ev_w_in() + (size_t)j * D * EV_IN : P.od_w_in() + (size_t)j * D * OD_N;
    const float* Wout = even ? P.ev_w_out() + (size_t)j * D * D : P.od_w_out() + (size_t)j * D * D;
    const float* Wg = P.w_gate() + (size_t)L * D * DFF; const float* Wu = P.w_up() + (size_t)L * D * DFF; const float* Wd = P.w_down() + (size_t)L * DFF * D;
    const int ldin = even ? EV_IN : OD_N;
    const int I_INA = even ? 16 * 64 : 16 * 48, I_INB = even ? 16 * 64 : 0, I_OUT = 16 * 32, I_POOL = even ? 0 : 32, I_G = 16 * 88, I_U = 16 * 88, I_D = 44 * 32;
    const int NITEMS = I_INA + I_INB + I_OUT + I_POOL + I_G + I_U + I_D;
    for (int it = gw; it < NITEMS; it += NGW) {
        int r = it;
        if (r < I_INA) { const int nblk = even ? 64 : 48; tr_item(Win, ldin, 0, gm, WIN, D, 0, scr, 64 * (r / nblk), 32 * (r % nblk), lane); continue; } r -= I_INA;
        if (r < I_INB) { tr_item(Win, ldin, 2056, gm, WIN, D, 2048, scr, 64 * (r / 64), 32 * (r % 64), lane); continue; } r -= I_INB;
        if (r < I_OUT) { tr_item(Wout, D, 0, nullptr, WOUT, D, 0, scr, 64 * (r / 32), 32 * (r % 32), lane); continue; } r -= I_OUT;
        if (r < I_POOL) { const int g = r >> 3, q = r & 7; tr_item(P.od_pw() + (size_t)(j * 4 + g) * 128 * 128, 128, 0, nullptr, (bf16*)(P.ws() + WS_WTP) + g * 128 * 128, 128, 0, scr, 64 * (q >> 2), 32 * (q & 3), lane); continue; } r -= I_POOL;
        if (r < I_G) { const int n0 = 32 * (r % 88); tr_item(Wg, DFF, 0, gf, WGU, D, (n0 >> 7) * 256 + (n0 & 127) - n0, scr, 64 * (r / 88), n0, lane); continue; } r -= I_G;
        if (r < I_U) { const int n0 = 32 * (r % 88); tr_item(Wu, DFF, 0, gf, WGU, D, (n0 >> 7) * 256 + (n0 & 127) + 128 - n0, scr, 64 * (r / 88), n0, lane); continue; } r -= I_U;
        tr_item(Wd, D, 0, nullptr, WD, DFF, 0, scr, 64 * (r / 32), 32 * (r % 32), lane);
    }
    if (even) {
        bf16* WTG = (bf16*)(P.ws() + WS_WTG);
        for (int idx = gw * 64 + lane; idx < 8 * D; idx += NGW * 64) { const int c = idx >> 10, k = idx & 1023; WTG[idx] = (bf16)f2bf(gm[k] * Win[(size_t)k * EV_IN + 2048 + c]); }
    }
}
__device__ __forceinline__ void prologue_rows(const Ptrs& P, int gw, int NGW, int lane) {
    bf16* XB = (bf16*)(P.ws() + WS_XB); float* SSQ = (float*)(P.ws() + WS_SSQ); float* ROT = (float*)(P.ws() + WS_ROT);
    for (int m = gw; m < M; m += NGW) {
        const GAS f32x4* xr = (const GAS f32x4*)(P.x() + (size_t)m * D) + lane; GAS unsigned long long* o8 = (GAS unsigned long long*)(XB + (size_t)m * D) + lane;
        float s = 0.f;
#pragma unroll
        for (int q = 0; q < 4; ++q) { const f32x4 v = xr[64 * q]; s += (v.x * v.x + v.y * v.y) + (v.z * v.z + v.w * v.w); o8[64 * q] = (unsigned long long)pk2(v.x, v.y) | ((unsigned long long)pk2(v.z, v.w) << 32); }
        s = wave_sum(s);
        if (lane < 16) SSQ[(size_t)m * 16 + lane] = lane == 0 ? s : 0.f;
    }
    for (int t = gw; t < SEQ; t += NGW) {
        const float inv = powf(10000.0f, -(float)(2 * lane) / 128.0f); const float ang = (float)t * inv; float sn, cs; sincosf(ang, &sn, &cs);
        ROT[((size_t)t * 64 + lane) * 2] = cs; ROT[((size_t)t * 64 + lane) * 2 + 1] = sn;
    }
}
__device__ __forceinline__ void final_norm(const Ptrs& P, int gw, int NGW, int lane) {
    for (int m = gw; m < M; m += NGW) {
        GAS f32x4* xr = (GAS f32x4*)(P.out() + (size_t)m * D) + lane; const GAS f32x4* gr = (const GAS f32x4*)P.g_fin() + lane;
        f32x4 v[4]; float s = 0.f;
#pragma unroll
        for (int q = 0; q < 4; ++q) { v[q] = xr[64 * q]; s += (v[q].x * v[q].x + v[q].y * v[q].y) + (v[q].z * v[q].z + v[q].w * v[q].w); }
        const float rs = 1.0f / sqrtf(wave_sum(s) * (1.0f / D) + EPS);
#pragma unroll
        for (int q = 0; q < 4; ++q) xr[64 * q] = v[q] * rs * gr[64 * q];
    }
}
__device__ __forceinline__ void gates_rows(const Ptrs& P, int j, int bx, int G, int tid) {
    const bf16* XB = (const bf16*)(P.ws() + WS_XB); const bf16* WTG = (const bf16*)(P.ws() + WS_WTG); const float* SSQ = (const float*)(P.ws() + WS_SSQ); float* GATES = (float*)(P.ws() + WS_GATES);
    const int c = tid & 7; const float bias = c < 4 ? P.ev_ib()[j * 4 + c] : P.ev_fb()[j * 4 + c - 4];
    for (int r0 = bx * 64; r0 < M; r0 += G * 64) {
        const int row = r0 + (tid >> 3);
        const GAS v4u* a = (const GAS v4u*)(XB + (size_t)row * D); const GAS v4u* w = (const GAS v4u*)(WTG + (size_t)c * D);
        float acc = 0.f;
#pragma unroll 4
        for (int k = 0; k < D / 8; ++k) { const v4u av = a[k], wv = w[k];
#pragma unroll
            for (int e = 0; e < 4; ++e) { acc += __builtin_bit_cast(float, av[e] << 16) * __builtin_bit_cast(float, wv[e] << 16); acc += __builtin_bit_cast(float, av[e] & 0xffff0000u) * __builtin_bit_cast(float, wv[e] & 0xffff0000u); } }
        float s = 0.f;
#pragma unroll
        for (int q = 0; q < 4; ++q) { const f32x4 p = *(const GAS f32x4*)(SSQ + (size_t)row * 16 + 4 * q); s += (p.x + p.y) + (p.z + p.w); }
        GATES[(size_t)row * 8 + c] = acc * (1.0f / sqrtf(s * (1.0f / D) + EPS)) + bias;
    }
}

__device__ __forceinline__ void ev_golden_item(const Ptrs& P, int j, LAS unsigned char* lds, int item, int tid) {
    const bf16* Z = (const bf16*)(P.ws() + WS_Z); const float* GATES = (const float*)(P.ws() + WS_GATES); const float* ROT = (const float*)(P.ws() + WS_ROT); bf16* MIXED = (bf16*)(P.ws() + WS_MIXED);
    const float* cw = P.ev_cw() + (size_t)j * 4 * 1024; const float* cb = P.ev_cb() + j * 1024; const float* ngm = P.ev_ngm() + j * 512; const float* ngr = P.ev_ngr() + j * 512;
    const int type = item >> 5, b = (item >> 2) & 7, h = item & 3;
    LAS float* qs = (LAS float*)lds; LAS float* ks = qs + 128; LAS float* vs = ks + 128; LAS float* part = vs + 128; LAS float* nq = part + 512; LAS float* xs = nq + 128;
    const int v = tid & 127, dq = tid >> 7;
    float C[32];
#pragma unroll
    for (int i = 0; i < 32; ++i) C[i] = 0.f;
    float nst = 0.f; const float gamma = 1.0f - exp2f(-5.0f - (float)h);
    for (int t = 0; t < SEQ; ++t) {
        const size_t row = (size_t)b * SEQ + t; const bf16* zr = Z + row * EV_N;
        if (type == 0) {
            if (tid < 256) { const int isk = tid >> 7, d = tid & 127, ch = isk * 512 + h * 128 + d; float acc = cb[ch];
                for (int tap = 0; tap < 4; ++tap) { const int tt = t - 3 + tap; if (tt >= 0) acc += cw[tap * 1024 + ch] * bf2f(Z[((size_t)b * SEQ + tt) * EV_N + ch]); }
                float val = acc * sigmoidf_(acc); if (isk) { val *= KSCALE; ks[d] = val; } else qs[d] = val; }
            else if (tid < 384) vs[tid - 256] = bf2f(zr[1024 + h * 128 + tid - 256]);
        } else {
            if (tid < 256) { const int isk = tid >> 7, d = tid & 127, fi = d & 63, base = 2048 + isk * 512 + h * 128; const float x1 = bf2f(zr[base + fi]), x2 = bf2f(zr[base + 64 + fi]);
                const float cs = ROT[((size_t)t * 64 + fi) * 2], sn = ROT[((size_t)t * 64 + fi) * 2 + 1]; float val = d < 64 ? x1 * cs - x2 * sn : x1 * sn + x2 * cs;
                if (isk) { val *= KSCALE; ks[d] = val; } else qs[d] = val; }
            else if (tid < 384) vs[tid - 256] = bf2f(zr[3072 + h * 128 + tid - 256]);
        }
        __syncthreads();
        float fi = 1.f, ff = gamma;
        if (type == 0) { fi = __expf(GATES[row * 8 + h]); ff = sigmoidf_(GATES[row * 8 + 4 + h]); }
        float p = 0.f; const float vv = vs[v];
#pragma unroll
        for (int dd = 0; dd < 32; ++dd) { const int d = 32 * dq + dd; C[dd] = ff * C[dd] + fi * ks[d] * vv; p += C[dd] * qs[d]; }
        part[dq * 128 + v] = p;
        if (type == 0 && tid < 128) { nst = ff * nst + fi * ks[tid]; nq[tid] = nst * qs[tid]; }
        __syncthreads();
        if (tid < 128) {
            float hv = (part[v] + part[128 + v]) + (part[256 + v] + part[384 + v]);
            if (type == 0) { float den = 0.f; for (int d = 0; d < 128; ++d) den += nq[d]; hv = hv / fmaxf(fabsf(den), 1.0f); hv *= sigmoidf_(bf2f(zr[1536 + h * 128 + v])); }
            xs[v] = hv;
        }
        __syncthreads();
        if (tid < 128) {
            float mean = 0.f; for (int d = 0; d < 128; ++d) mean += xs[d]; mean *= (1.0f / 128.0f);
            float var = 0.f; for (int d = 0; d < 128; ++d) { const float dv = xs[d] - mean; var += dv * dv; } var *= (1.0f / 128.0f);
            float y = (xs[v] - mean) * (1.0f / sqrtf(var + EPS));
            if (type == 0) { y *= ngm[h * 128 + v]; MIXED[row * D + h * 128 + v] = (bf16)f2bf(y); }
            else { y *= ngr[h * 128 + v]; const float gg = bf2f(zr[3584 + h * 128 + v]); y *= gg * sigmoidf_(gg); MIXED[row * D + 512 + h * 128 + v] = (bf16)f2bf(y); }
        }
    }
    __syncthreads();
}
__device__ __forceinline__ void od_golden_row(const Ptrs& P, int j, LAS unsigned char* lds, int row, int tid) {
    const bf16* Z = (const bf16*)(P.ws() + WS_Z); bf16* MIXED = (bf16*)(P.ws() + WS_MIXED);
    LAS float* pl = (LAS float*)lds; LAS float* red = pl + 512;
    const int b = row >> 11, t = row & 2047, c = tid, wave = tid >> 6, lane = tid & 63;
    const bf16* zb = Z + (size_t)b * SEQ * OD_N;
    const float* dw = P.od_dw() + (size_t)j * 31 * 512; float acc = P.od_db()[j * 512 + c];
    for (int k = 0; k < 31; ++k) { const int tt = t - 30 + k; if (tt >= 0) { const float ga = bf2f(zb[(size_t)tt * OD_N + 512 + c]), gb = bf2f(zb[(size_t)tt * OD_N + 1024 + c]); acc += dw[k * 512 + c] * ga * sigmoidf_(gb); } }
    const float mean = block_sum(acc, red, wave, lane) * (1.0f / 512.0f); const float dv = acc - mean;
    const float var = block_sum(dv * dv, red, wave, lane) * (1.0f / 512.0f);
    float y = dv * (1.0f / sqrtf(var + EPS)) * P.od_ng()[j * 512 + c] + P.od_nb()[j * 512 + c]; y = y * sigmoidf_(y);
    MIXED[(size_t)row * D + 512 + c] = (bf16)f2bf(y);
    const int g = c >> 7, w = 2 << g, cnt = (t + 1) < w ? (t + 1) : w; float s = 0.f;
    for (int k = 0; k < cnt; ++k) s += bf2f(zb[(size_t)(t - k) * OD_N + c]);
    pl[c] = s / (float)cnt - bf2f(zb[(size_t)t * OD_N + c]);
    __syncthreads();
    const float* pw = P.od_pw() + (size_t)(j * 4 + g) * 128 * 128; const int o = c & 127; float a2 = 0.f;
    for (int i = 0; i < 128; ++i) a2 += pl[g * 128 + i] * pw[i * 128 + o];
    MIXED[(size_t)row * D + c] = (bf16)f2bf(a2 * P.od_ps()[j * 512 + c]);
    __syncthreads();
}

struct Args { const float* in[23]; float* out; unsigned char* ws; int ph_lo, ph_hi; };
constexpr int N_PHASES = 2 + 6 * DEPTH;
#ifndef MK_ONE_LAUNCH
#define MK_ONE_LAUNCH 1
#endif
__global__ void __launch_bounds__(NWAVES * 64, 2) mk_fwd(Args args) {
    extern __shared__ __attribute__((aligned(16))) unsigned char lds_raw[];
    LAS unsigned char* lds = (LAS unsigned char*)lds_raw;
    volatile LAS unsigned* MISC = (volatile LAS unsigned*)(lds + MISC_OFF);
    const int G = gridDim.x, bx = blockIdx.x;
    const int vcu = (G % 8 == 0) ? (bx % 8) * (G / 8) + bx / 8 : bx;
    const int NGW = G * NWAVES;
#define GW (vcu * NWAVES + wave)
    const Ptrs P;
    gu32* ctl = (gu32*)(P.ws() + WS_CTL);
    for (int u = threadIdx.x; u < (LDS_BYTES - LDSCTL_OFF) / 4; u += NWAVES * 64) ((LAS unsigned*)(lds + LDSCTL_OFF))[u] = 0u;
    __syncthreads();
    const int lo = P.ph_lo(), hi = P.ph_hi();
    const bool use_bar = (hi - lo) > 1;
    XcdBarrier bar; bar.bar = (unsigned*)(ctl + CW_BAR); bar.x = 0; bar.st = nullptr;
    if (use_bar) bar = xcd_barrier_post((unsigned*)(ctl + CW_BAR), MISC + 8);
#define IN(k) (lo <= (k) && (k) < hi)
#define FRESH() int tid = threadIdx.x; asm volatile("" : "+v"(tid)); const int lane = tid & 63, wave = __builtin_amdgcn_readfirstlane(tid >> 6); (void)lane; (void)wave
#define SEAM(k) do { if (IN(k) && IN((k) + 1)) xcd_barrier(bar); } while (0)

#define XB ((bf16*)(P.ws() + WS_XB))
#define MIXED ((bf16*)(P.ws() + WS_MIXED))
#define ZB ((bf16*)(P.ws() + WS_Z))
#define ACT ((bf16*)(P.ws() + WS_Z))
#define SSQ ((float*)(P.ws() + WS_SSQ))
    if (IN(0)) { FRESH(); prologue_rows(P, GW, NGW, lane); }
    SEAM(0);
    for (int L = 0; L < DEPTH; ++L) {
        const int p0 = 1 + 6 * L, j = L >> 1; const bool even = (L & 1) == 0;
        if (IN(p0)) { FRESH(); convert_layer(P, L, lds, GW, NGW, wave, lane); }
        SEAM(p0);
        if (IN(p0 + 1)) {
            const int N = even ? EV_N : OD_N;
            pg8::Gemm g{XB, (const bf16*)(P.ws() + WS_WIN), M, N, D}; pg8::StaticOrder S; S.init(M, N, G, bx);
            pg8::EpiZ E{ZB, N, SSQ};
            pg8::gemm_phase<pg8::EpiZ, pg8::StaticOrder, true, true>(lds + RING_OFF, g, S, E);
            if (even) { FRESH(); gates_rows(P, j, bx, G, tid); }
        }
        SEAM(p0 + 1);
        if (IN(p0 + 2)) {
            FRESH();
            if (even) { for (int it = bx; it < 64; it += G) ev_golden_item(P, j, lds, it, tid); }
            else { for (int row = bx; row < M; row += G) od_golden_row(P, j, lds, row, tid); }
        }
        SEAM(p0 + 2);
        if (IN(p0 + 3)) {
            pg8::Gemm g{MIXED, (const bf16*)(P.ws() + WS_WOUT), M, D, D}; pg8::StaticOrder S; S.init(M, D, G, bx);
            pg8::EpiRes E{L == 0 ? P.x() : P.out(), P.out(), XB, SSQ, D};
            pg8::gemm_phase<pg8::EpiRes, pg8::StaticOrder, true, true>(lds + RING_OFF, g, S, E);
        }
        SEAM(p0 + 3);
        if (IN(p0 + 4)) {
            pg8::Gemm g{XB, (const bf16*)(P.ws() + WS_WGU), M, NGU, D}; pg8::StaticOrder S; S.init(M, NGU, G, bx);
            pg8::EpiSwiGLU E{ACT, DFF, SSQ};
            pg8::gemm_phase<pg8::EpiSwiGLU, pg8::StaticOrder, true, true>(lds + RING_OFF, g, S, E);
        }
        SEAM(p0 + 4);
        if (IN(p0 + 5)) {
            pg8::Gemm g{ACT, (const bf16*)(P.ws() + WS_WD), M, D, DFF}; pg8::StaticOrder S; S.init(M, D, G, bx);
            pg8::EpiRes E{P.out(), P.out(), XB, SSQ, D};
            pg8::gemm_phase<pg8::EpiRes, pg8::StaticOrder, true, true>(lds + RING_OFF, g, S, E);
        }
        SEAM(p0 + 5);
    }
    if (IN(N_PHASES - 1)) { FRESH(); final_norm(P, GW, NGW, lane); }
#undef IN
#undef SEAM
#undef FRESH
#undef GW
#undef XB
#undef MIXED
#undef ZB
#undef ACT
#undef SSQ
}

extern "C" void kernel_launch(void* const* d_in, const int* in_sizes, int n_in, void* d_out, int out_size, void* d_ws, size_t ws_size, hipStream_t stream) {
    static int grid = 0;
    if (grid == 0) {
        if (n_in != 23 || in_sizes[0] != M * D || out_size != M * D || ws_size < WS_END) { fprintf(stderr, "kernel_launch: unexpected shapes (n_in %d, in0 %d, out %d, ws %zu)\n", n_in, n_in > 0 ? in_sizes[0] : -1, out_size, ws_size); grid = -1; return; }
        int dev = 0, cus = 0, per_cu = 0;
        if (hipGetDevice(&dev) != hipSuccess || hipDeviceGetAttribute(&cus, hipDeviceAttributeMultiprocessorCount, dev) != hipSuccess) { grid = -1; return; }
        if (hipFuncSetAttribute((const void*)mk_fwd, hipFuncAttributeMaxDynamicSharedMemorySize, LDS_BYTES) != hipSuccess) { fprintf(stderr, "kernel_launch: hipFuncSetAttribute failed\n"); grid = -1; return; }
        if (hipOccupancyMaxActiveBlocksPerMultiprocessor(&per_cu, (const void*)mk_fwd, NWAVES * 64, LDS_BYTES) != hipSuccess || per_cu < 1) { fprintf(stderr, "kernel_launch: occupancy query reports %d blocks per CU\n", per_cu); per_cu = 1; }
        (void)hipGetLastError();
        grid = cus;
        if (grid > 256) grid = 256;
    }
    if (grid < 0) return;
    (void)hipMemsetAsync((char*)d_ws + WS_CTL, 0, CTL_ZERO_BYTES, stream);
    Args a{};
    for (int i = 0; i < 23; ++i) a.in[i] = (const float*)d_in[i];
    a.out = (float*)d_out; a.ws = (unsigned char*)d_ws;
#if MK_ONE_LAUNCH
    a.ph_lo = 0; a.ph_hi = N_PHASES;
    hipLaunchKernelGGL(mk_fwd, dim3(grid), dim3(NWAVES * 64), LDS_BYTES, stream, a);
#else
    for (int ph = 0; ph < N_PHASES; ++ph) { a.ph_lo = ph; a.ph_hi = ph + 1; hipLaunchKernelGGL(mk_fwd, dim3(grid), dim3(NWAVES * 64), LDS_BYTES, stream, a); }
#endif
}
```

```cpp
#include <hip/hip_runtime.h>
#include <cstdio>
#include <cstdint>
#include <cmath>

template <int MASK> __device__ __forceinline__ float sx(float v, int lane) {
    if constexpr (MASK < 32) return __builtin_bit_cast(float, __builtin_amdgcn_ds_swizzle(__builtin_bit_cast(int, v), (MASK << 10) | 0x1f));
    else return __builtin_bit_cast(float, __builtin_amdgcn_ds_bpermute((lane ^ 32) << 2, __builtin_bit_cast(int, v)));
}
template <int MASK> __device__ __forceinline__ unsigned sxu(unsigned v, int lane) {
    if constexpr (MASK < 32) return (unsigned)__builtin_amdgcn_ds_swizzle((int)v, (MASK << 10) | 0x1f);
    else return (unsigned)__builtin_amdgcn_ds_bpermute((lane ^ 32) << 2, (int)v);
}
__device__ __forceinline__ float shup(float v, int o, int lane) { return __builtin_bit_cast(float, __builtin_amdgcn_ds_bpermute((lane - o) << 2, __builtin_bit_cast(int, v))); }
namespace pg8 {
#define PG8_LAS __attribute__((address_space(3)))
typedef unsigned short bf16_t;
typedef short bf16x8 __attribute__((ext_vector_type(8)));
typedef float f32x4 __attribute__((ext_vector_type(4)));
typedef unsigned u32x4 __attribute__((ext_vector_type(4)));
constexpr int BM = 256, BK = 64, HALF = 128, HTB = HALF * BK * 2  , STAGE_BYTES = 8 * HTB, NXCD = 8, WGM = 8;

__host__ __device__ __forceinline__ int lds_byte(int r, int c) { const int st = (r >> 4) * 2 + (c >> 5), rr = r & 15, cc = c & 31, ob = rr * 64 + cc * 2; return st * 1024 + (ob ^ (((ob >> 9) & 1) << 5)); }
__host__ __device__ __forceinline__ void stage_rc(int b, int& R, int& C) { const int st = b / 1024, sb = b % 1024, swz = sb ^ (((sb >> 9) & 1) << 5); R = (st >> 1) * 16 + swz / 64; C = (st & 1) * 32 + (swz % 64) / 2; }
__host__ __device__ __forceinline__ int perm32(int rho) { const int n = rho >> 4, i = rho & 15; return 8 * (i >> 2) + 4 * n + (i & 3); }

struct Unit { int pm, pn; };
struct Gemm { const bf16_t* A; const bf16_t* Bt; int M, N, K; };

struct StaticOrder {
    int nM, nN, nwg, G, c;
    __host__ __device__ void init(int M, int N, int G_, int c_) { nM = M / BM; nN = N / BM; nwg = nM * nN; G = G_; c = c_; }
    __host__ __device__ bool next(int i, Unit& u) const {
        const long L = (long)i * G + c; if (L >= nwg) return false;
        int wgid = (int)L; { const int q = nwg / NXCD, r = nwg % NXCD, xcd = wgid % NXCD, off = wgid / NXCD; wgid = (xcd < r ? xcd * (q + 1) : r * (q + 1) + (xcd - r) * q) + off; }
        const int nig = WGM * nN, gid = wgid / nig, fm = gid * WGM, gsz = (nM - fm) < WGM ? (nM - fm) : WGM;
        u.pm = fm + ((wgid % nig) % gsz); u.pn = (wgid % nig) / gsz; return true;
    }
    __device__ __forceinline__ void a_ready(const Unit&) const {}
    __device__ __forceinline__ void done(const Unit&) const {}
};


__device__ __forceinline__ unsigned cvt_pk_bf16(float lo, float hi) { unsigned r; asm volatile("v_cvt_pk_bf16_f32 %0, %1, %2" : "=v"(r) : "v"(lo), "v"(hi)); return r; }
typedef float f32x2 __attribute__((ext_vector_type(2)));

typedef float f32x2 __attribute__((ext_vector_type(2)));
typedef unsigned u32x2 __attribute__((ext_vector_type(2)));
constexpr float RMS_EPS = 1e-6f;
__device__ __forceinline__ float row_rstd(const float* ssq, int row, int fq, int lane) {
    const f32x4 p = *(const f32x4*)(ssq + (size_t)row * 16 + 4 * fq);
    float s = (p[0] + p[1]) + (p[2] + p[3]);
    s += sx<16>(s, lane); s += sx<32>(s, lane);
    return __builtin_amdgcn_rsqf(s * (1.0f / 1024.0f) + RMS_EPS);
}
__device__ __forceinline__ void row_rstd8(const float* ssq, int row0, int fq, int lane, float (&rs)[2][4]) {
    f32x4 p[2][4];
#pragma unroll
    for (int ai = 0; ai < 2; ++ai)
#pragma unroll
        for (int m = 0; m < 4; ++m) p[ai][m] = *(const f32x4*)(ssq + (size_t)(row0 + ai * HALF + m * 16) * 16 + 4 * fq);
    asm volatile("" : "+v"(p[0][0]), "+v"(p[0][1]), "+v"(p[0][2]), "+v"(p[0][3]), "+v"(p[1][0]), "+v"(p[1][1]), "+v"(p[1][2]), "+v"(p[1][3]));
#pragma unroll
    for (int ai = 0; ai < 2; ++ai)
#pragma unroll
        for (int m = 0; m < 4; ++m) { float s = (p[ai][m][0] + p[ai][m][1]) + (p[ai][m][2] + p[ai][m][3]); s += sx<16>(s, lane); s += sx<32>(s, lane); rs[ai][m] = __builtin_amdgcn_rsqf(s * (1.0f / 1024.0f) + RMS_EPS); }
}
struct EpiZ {
    static constexpr bool PERM = true, AFTER_DRAIN = false;
    bf16_t* O; int ldc; const float* ssq;
    __device__ __forceinline__ void operator()(const f32x4 (&acc)[2][2][4][2], const Unit& u, int wr, int wc, int fr, int fq) const {
        const int row0 = u.pm * BM + wr * 64 + fr, col0 = u.pn * BM + wc * 32 + 8 * fq;
        float rsv[2][4]; row_rstd8(ssq, row0, fq, fq * 16 + fr, rsv);
#pragma unroll
        for (int ai = 0; ai < 2; ++ai)
#pragma unroll
            for (int m = 0; m < 4; ++m) { const int row = row0 + ai * HALF + m * 16; const float rs = rsv[ai][m];
                bf16_t* rowp = O + (size_t)row * ldc + col0;
#pragma unroll
                for (int bj = 0; bj < 2; ++bj) { const f32x4 v0 = acc[ai][bj][m][0] * rs, v1 = acc[ai][bj][m][1] * rs;
                    u32x4 w; w.x = cvt_pk_bf16(v0[0], v0[1]); w.y = cvt_pk_bf16(v0[2], v0[3]); w.z = cvt_pk_bf16(v1[0], v1[1]); w.w = cvt_pk_bf16(v1[2], v1[3]);
                    *(u32x4*)(rowp + bj * HALF) = w; } }
    }
};
struct EpiSwiGLU {
    static constexpr bool PERM = true, AFTER_DRAIN = false;
    bf16_t* O; int ldc; const float* ssq;
    __device__ __forceinline__ void operator()(const f32x4 (&acc)[2][2][4][2], const Unit& u, int wr, int wc, int fr, int fq) const {
        const int row0 = u.pm * BM + wr * 64 + fr, col0 = u.pn * HALF + wc * 32 + 8 * fq;
        float rsv[2][4]; row_rstd8(ssq, row0, fq, fq * 16 + fr, rsv);
#pragma unroll
        for (int ai = 0; ai < 2; ++ai)
#pragma unroll
            for (int m = 0; m < 4; ++m) { const int row = row0 + ai * HALF + m * 16; const float rs = rsv[ai][m];
                float o[8];
#pragma unroll
                for (int n = 0; n < 2; ++n)
#pragma unroll
                    for (int e = 0; e < 4; ++e) { const float g = acc[ai][0][m][n][e] * rs, up = acc[ai][1][m][n][e] * rs;
                        const float sg = g * __builtin_amdgcn_rcpf(1.0f + __builtin_amdgcn_exp2f(-1.4426950408889634f * g)); o[4 * n + e] = sg * up; }
                u32x4 w; w.x = cvt_pk_bf16(o[0], o[1]); w.y = cvt_pk_bf16(o[2], o[3]); w.z = cvt_pk_bf16(o[4], o[5]); w.w = cvt_pk_bf16(o[6], o[7]);
                *(u32x4*)(O + (size_t)row * ldc + col0) = w; }
    }
};
struct EpiRes {
    static constexpr bool PERM = false, AFTER_DRAIN = false;
    bf16_t* xb; float* ssq; int ldc;
    __device__ __forceinline__ void operator()(const f32x4 (&acc)[2][2][4][2], const Unit& u, int wr, int wc, int fr, int fq) const {
        const int row0 = u.pm * BM + wr * 64 + fr, col0 = u.pn * BM + wc * 32 + 4 * fq;
#pragma unroll
        for (int ai = 0; ai < 2; ++ai)
#pragma unroll
            for (int m = 0; m < 4; ++m) { const int row = row0 + ai * HALF + m * 16; const size_t off = (size_t)row * ldc + col0; float q = 0.f;
#pragma unroll
                for (int bj = 0; bj < 2; ++bj)
#pragma unroll
                    for (int n = 0; n < 2; ++n) { const size_t o2 = off + bj * HALF + n * 16; const u32x2 xo = *(const u32x2*)(xb + o2);
                        f32x4 xn; xn[0] = __builtin_bit_cast(float, xo.x << 16); xn[1] = __builtin_bit_cast(float, xo.x & 0xffff0000u); xn[2] = __builtin_bit_cast(float, xo.y << 16); xn[3] = __builtin_bit_cast(float, xo.y & 0xffff0000u);
                        xn += acc[ai][bj][m][n];
                        u32x2 w; w.x = cvt_pk_bf16(xn[0], xn[1]); w.y = cvt_pk_bf16(xn[2], xn[3]); *(u32x2*)(xb + o2) = w;
                        q += (xn[0] * xn[0] + xn[1] * xn[1]) + (xn[2] * xn[2] + xn[3] * xn[3]); }
                q += sx<16>(q, fq * 16 + fr); q += sx<32>(q, fq * 16 + fr);
                if (fq == 0) ssq[(size_t)row * 16 + u.pn * 4 + wc] = q;
                asm volatile("" ::: "memory"); }
    }
};


template <class Epi, class Sched, bool ALIGN_EPI = false, bool SP2 = false>
__device__ __forceinline__ void gemm_phase(PG8_LAS unsigned char* lds, const Gemm g, const Sched& S, const Epi& E, int tid_in) {
    int tid_ = tid_in; asm volatile("" : "+v"(tid_));
    const int tid = tid_, wid = __builtin_amdgcn_readfirstlane(tid >> 6), lane = tid & 63, wr = wid >> 2, wc = wid & 3, fr = lane & 15, fq = lane >> 4;
    const int K = g.K, nt = K / BK;
    unsigned voffA[2], voffB[2];
#pragma unroll
    for (int i = 0; i < 2; ++i) { int R, C; stage_rc(tid * 16 + i * 8192, R, C); const int Rb = Epi::PERM ? ((R & ~31) + perm32(R & 31)) : R;
        voffA[i] = (unsigned)(R * K + C) * 2u; voffB[i] = (unsigned)(Rb * K + C) * 2u; }
    const size_t kstep = (size_t)(BK * 2);
    const size_t hstep = (size_t)HALF * K * 2;
    const size_t tstep = 2 * hstep;
    const unsigned ldsw = (unsigned)wid * 1024u;
    const int aoff = lds_byte(wr * 64 + fr, fq * 8), boff = lds_byte(wc * 32 + fr, fq * 8);
#define PG8_SA(b, h) (((b) * 2 + (h)) * HTB)
#define PG8_SB(b, h) ((4 + (b) * 2 + (h)) * HTB)
#define PG8_STAGE(bufoff, gbase, voff) do { _Pragma("unroll") for (int _i = 0; _i < 2; ++_i) \
        __builtin_amdgcn_global_load_lds((const unsigned*)((const char*)(gbase) + (voff)[_i]), (PG8_LAS unsigned*)(lds + (bufoff) + ldsw + _i * 8192), 16, 0, 0); } while (0)
#define PG8_LDA(dst, b, h) do { _Pragma("unroll") for (int m = 0; m < 4; ++m) _Pragma("unroll") for (int k = 0; k < 2; ++k) dst[m][k] = *(const PG8_LAS bf16x8*)(lds + PG8_SA(b, h) + aoff + m * 2048 + k * 1024); } while (0)
#define PG8_LDB(dst, b, h) do { _Pragma("unroll") for (int n = 0; n < 2; ++n) _Pragma("unroll") for (int k = 0; k < 2; ++k) dst[n][k] = *(const PG8_LAS bf16x8*)(lds + PG8_SB(b, h) + boff + n * 2048 + k * 1024); } while (0)
#define PG8_MMA(ai, bj, At, Bt) do { __builtin_amdgcn_s_setprio(1); _Pragma("unroll") for (int m = 0; m < 4; ++m) _Pragma("unroll") for (int n = 0; n < 2; ++n) _Pragma("unroll") for (int k = 0; k < 2; ++k) \
        acc[ai][bj][m][n] = __builtin_amdgcn_mfma_f32_16x16x32_bf16(Bt[n][k], At[m][k], acc[ai][bj][m][n], 0, 0, 0); __builtin_amdgcn_s_setprio(0); } while (0)
#define PG8_WAIT_V(n) asm volatile("s_waitcnt vmcnt(" #n ")" ::: "memory")
#define PG8_WAIT_L(n) asm volatile("s_waitcnt lgkmcnt(" #n ")" ::: "memory")
#define PG8_BAR __builtin_amdgcn_s_barrier()
#define PG8_SCHED __builtin_amdgcn_sched_barrier(0)
    Unit cur, nxt; int ui = 0;
    if (!S.next(0, cur)) return;
    f32x4 acc[2][2][4][2];
#pragma unroll
    for (int a = 0; a < 2; ++a)
#pragma unroll
        for (int b = 0; b < 2; ++b)
#pragma unroll
            for (int m = 0; m < 4; ++m)
#pragma unroll
                for (int n = 0; n < 2; ++n) acc[a][b][m][n] = (f32x4){0.f, 0.f, 0.f, 0.f};
    bf16x8 At[4][2], B0[2][2], B1[2][2];
    const char* cA = (const char*)g.A + (size_t)cur.pm * tstep; const char* cB = (const char*)g.Bt + (size_t)cur.pn * tstep;
    S.a_ready(cur);
    if constexpr (SP2) {
        PG8_STAGE(PG8_SB(0, 0), cB, voffB); PG8_STAGE(PG8_SB(0, 1), cB + hstep, voffB); PG8_STAGE(PG8_SA(0, 0), cA, voffA); PG8_STAGE(PG8_SA(0, 1), cA + hstep, voffA);
        if (wr == 1) PG8_BAR;
        PG8_WAIT_V(2); PG8_BAR;
        PG8_STAGE(PG8_SB(1, 0), cB + kstep, voffB); PG8_STAGE(PG8_SA(1, 0), cA + kstep, voffA); PG8_STAGE(PG8_SB(1, 1), cB + hstep + kstep, voffB);
        PG8_WAIT_V(6); PG8_BAR;
    } else {
        PG8_STAGE(PG8_SB(0, 0), cB, voffB); PG8_STAGE(PG8_SA(0, 0), cA, voffA); PG8_STAGE(PG8_SB(0, 1), cB + hstep, voffB); PG8_STAGE(PG8_SA(0, 1), cA + hstep, voffA);
        if (wr == 1) PG8_BAR;
        PG8_WAIT_V(4); PG8_BAR;
        PG8_STAGE(PG8_SB(1, 0), cB + kstep, voffB); PG8_STAGE(PG8_SA(1, 0), cA + kstep, voffA); PG8_STAGE(PG8_SB(1, 1), cB + hstep + kstep, voffB);
        PG8_WAIT_V(6); PG8_BAR;
    }
    for (;;) {
        const bool has_next = S.next(ui + 1, nxt);
        const char* nA = has_next ? (const char*)g.A + (size_t)nxt.pm * tstep : cA; const char* nB = has_next ? (const char*)g.Bt + (size_t)nxt.pn * tstep : cB;
        for (int t = 0; t < nt; t += 2) {
            const bool last = (t == nt - 2);
            const char* a1 = cA + (size_t)(t + 1) * kstep;
            const char* a2 = last ? nA : cA + (size_t)(t + 2) * kstep; const char* b2 = last ? nB : cB + (size_t)(t + 2) * kstep;
            const char* a3 = a2 + kstep; const char* b3 = b2 + kstep;
            if (last && has_next) S.a_ready(nxt);
            if constexpr (SP2) {
            PG8_LDB(B0, 0, 0); PG8_LDB(B1, 0, 1); PG8_SCHED; PG8_LDA(At, 0, 0); PG8_STAGE(PG8_SA(1, 1), a1 + hstep, voffA);
            PG8_WAIT_V(8); PG8_WAIT_L(0); PG8_BAR; PG8_MMA(0, 0, At, B0); PG8_MMA(0, 1, At, B1); PG8_BAR; PG8_SCHED;
            PG8_LDA(At, 0, 1); PG8_STAGE(PG8_SB(0, 0), b2, voffB); PG8_STAGE(PG8_SB(0, 1), b2 + hstep, voffB); PG8_STAGE(PG8_SA(0, 0), a2, voffA);
            PG8_WAIT_V(8); PG8_WAIT_L(0); PG8_BAR; PG8_MMA(1, 0, At, B0); PG8_MMA(1, 1, At, B1); PG8_BAR; PG8_SCHED;
            PG8_LDB(B0, 1, 0); PG8_LDB(B1, 1, 1); PG8_SCHED; PG8_LDA(At, 1, 0); PG8_STAGE(PG8_SA(0, 1), a2 + hstep, voffA);
            PG8_WAIT_V(8); PG8_WAIT_L(0); PG8_BAR; PG8_MMA(0, 0, At, B0); PG8_MMA(0, 1, At, B1); PG8_BAR; PG8_SCHED;
            PG8_LDA(At, 1, 1); PG8_STAGE(PG8_SB(1, 0), b3, voffB); PG8_STAGE(PG8_SB(1, 1), b3 + hstep, voffB); PG8_STAGE(PG8_SA(1, 0), a3, voffA);
            PG8_WAIT_V(8); PG8_WAIT_L(0); PG8_BAR; PG8_MMA(1, 0, At, B0); PG8_MMA(1, 1, At, B1); PG8_BAR; PG8_SCHED;
            } else {
            PG8_LDB(B0, 0, 0); PG8_SCHED; PG8_LDA(At, 0, 0); PG8_STAGE(PG8_SA(1, 1), a1 + hstep, voffA);
            PG8_WAIT_L(8); PG8_BAR; PG8_WAIT_L(0); PG8_MMA(0, 0, At, B0); PG8_BAR; PG8_SCHED;
            PG8_LDB(B1, 0, 1); PG8_STAGE(PG8_SB(0, 0), b2, voffB);
            PG8_BAR; PG8_WAIT_L(0); PG8_MMA(0, 1, At, B1); PG8_BAR;
            PG8_LDA(At, 0, 1); PG8_STAGE(PG8_SA(0, 0), a2, voffA);
            PG8_BAR; PG8_WAIT_L(0); PG8_MMA(1, 0, At, B0); PG8_BAR; PG8_SCHED;
            PG8_STAGE(PG8_SB(0, 1), b2 + hstep, voffB);
            PG8_WAIT_V(6); PG8_BAR; PG8_MMA(1, 1, At, B1); PG8_BAR;
            PG8_LDB(B0, 1, 0); PG8_SCHED; PG8_LDA(At, 1, 0); PG8_STAGE(PG8_SA(0, 1), a2 + hstep, voffA);
            PG8_WAIT_L(8); PG8_BAR; PG8_WAIT_L(0); PG8_MMA(0, 0, At, B0); PG8_BAR; PG8_SCHED;
            PG8_LDB(B1, 1, 1); PG8_STAGE(PG8_SB(1, 0), b3, voffB);
            PG8_BAR; PG8_WAIT_L(0); PG8_MMA(0, 1, At, B1); PG8_BAR;
            PG8_LDA(At, 1, 1); PG8_STAGE(PG8_SA(1, 0), a3, voffA);
            PG8_BAR; PG8_WAIT_L(0); PG8_MMA(1, 0, At, B0); PG8_BAR; PG8_SCHED;
            PG8_STAGE(PG8_SB(1, 1), b3 + hstep, voffB);
            PG8_WAIT_V(6); PG8_BAR; PG8_MMA(1, 1, At, B1); PG8_BAR;
            }
        }
        if constexpr (ALIGN_EPI) { if (wr == 0) PG8_BAR; }
        if constexpr (!Epi::AFTER_DRAIN) { E(acc, cur, wr, wc, fr, fq); S.done(cur); }
        if (!has_next) break;
#pragma unroll
        for (int a = 0; a < 2; ++a)
#pragma unroll
            for (int b = 0; b < 2; ++b)
#pragma unroll
                for (int m = 0; m < 4; ++m)
#pragma unroll
                    for (int n = 0; n < 2; ++n) acc[a][b][m][n] = (f32x4){0.f, 0.f, 0.f, 0.f};
        cur = nxt; cA = nA; cB = nB; ++ui;
        if constexpr (ALIGN_EPI) { if (wr == 1) PG8_BAR; }
    }
    PG8_WAIT_V(0);
    if constexpr (!ALIGN_EPI) { if (wr == 0) PG8_BAR; }
    PG8_BAR;
    if constexpr (Epi::AFTER_DRAIN) { E.fused(acc, cur, wr, wc, fr, fq, lds, wid, lane); S.done(cur); }
#undef PG8_SA
#undef PG8_SB
#undef PG8_STAGE
#undef PG8_LDA
#undef PG8_LDB
#undef PG8_MMA
#undef PG8_WAIT_V
#undef PG8_WAIT_L
#undef PG8_BAR
#undef PG8_SCHED
}
}


constexpr int NWAVES = 8;
constexpr int BATCH = 8, SEQ = 2048, D = 1024, M = BATCH * SEQ, DEPTH = 4, DFF = 2816, NGU = 2 * DFF;
constexpr int EV_N = 4096, EV_IN = 4104, OD_N = 1536, HD = 128, CHUNK = 128;
constexpr float EPS = 1e-6f;
constexpr float KSCALE = 0.08838834764831845f;
constexpr size_t MiB = 1u << 20;
constexpr size_t WS_CTL = 0, CTL_ZERO_BYTES = 65536;
constexpr size_t WS_ROT = 1 * MiB;
constexpr size_t WS_GATES = 2 * MiB;
constexpr size_t WS_WTG = 2 * MiB + 512 * 1024;
constexpr size_t WS_WTP = WS_WTG + 65536;
constexpr size_t WS_SSQ = 3 * MiB;
constexpr size_t WS_WIN_A = 4 * MiB;
constexpr size_t WS_WIN_B = 12 * MiB;
constexpr size_t WS_WOUT = 16 * MiB;
constexpr size_t WS_WGU_A = 24 * MiB, WS_WD_A = 35 * MiB;
constexpr size_t WS_WGU_B = 41 * MiB, WS_WD_B = 52 * MiB;
constexpr size_t WS_XB = 58 * MiB;
constexpr size_t WS_MIXED = 90 * MiB;
constexpr size_t WS_Z = 122 * MiB;
constexpr size_t WS_END = 250 * MiB;
constexpr int CW_TMO = 0, CW_CODE = 1, CW_BAR = 4096;
constexpr int RING_OFF = 0, RING_BYTES = 131072;
constexpr int LDSCTL_OFF = RING_BYTES, MISC_OFF = LDSCTL_OFF + 320;
constexpr int LDS_BYTES = 147456;


#define GAS __attribute__((address_space(1)))
#define LAS __attribute__((address_space(3)))
typedef unsigned short bf16;
typedef unsigned v4u __attribute__((ext_vector_type(4)));
typedef float f32x4 __attribute__((ext_vector_type(4)));
typedef short bf16x8 __attribute__((ext_vector_type(8)));
typedef GAS unsigned gu32;
typedef GAS unsigned long long gu64;
#define RLX_AGENT __ATOMIC_RELAXED, __HIP_MEMORY_SCOPE_AGENT
#define LDS_WAIT() asm volatile("s_waitcnt lgkmcnt(0)" ::: "memory")
#define VM_WAIT() asm volatile("s_waitcnt vmcnt(0)" ::: "memory")
__device__ __forceinline__ unsigned long long rt() { return __builtin_amdgcn_s_memrealtime(); }
__device__ __forceinline__ unsigned f2bf(float f) { unsigned u = __builtin_bit_cast(unsigned, f); return (u + 0x7fffu + ((u >> 16) & 1u)) >> 16; }
typedef float f32x2_cv __attribute__((ext_vector_type(2))); typedef __bf16 bf16x2_cv __attribute__((ext_vector_type(2)));
__device__ __forceinline__ unsigned pk2(float lo, float hi) { const f32x2_cv v = {lo, hi}; return __builtin_bit_cast(unsigned, __builtin_convertvector(v, bf16x2_cv)); }

#define XB_TMO      128
#define XB_XCNT(j)  (256  + 64 * (j))
#define XB_XSUB(j)  (1280 + 64 * (j))
#define XB_XGEN(j)  (2304 + 64 * (j))
#define XB_TOP      3328
#define XB_TOPGEN   3392
#define XCD_BAR_WORDS 3456
#define XB_SPIN_CAP (1u << 18)

__device__ __forceinline__ unsigned xb_ld(unsigned* p)              { return __hip_atomic_load(p, __ATOMIC_RELAXED, __HIP_MEMORY_SCOPE_AGENT); }
__device__ __forceinline__ unsigned xb_add(unsigned* p, unsigned v) { return __hip_atomic_fetch_add(p, v, __ATOMIC_RELAXED, __HIP_MEMORY_SCOPE_AGENT); }
__device__ __forceinline__ unsigned xb_xcc_id() { return (unsigned)__builtin_amdgcn_s_getreg((3 << 11) | 20) & 0xFu; }
#define XB_SPIN(cond, bar) do { unsigned _sp = 0; while (cond) { __builtin_amdgcn_s_sleep(0); \
    if ((++_sp & 255u) == 0u) { if (xb_ld(&(bar)[XB_TMO])) break; if (_sp > XB_SPIN_CAP) { atomicAdd(&(bar)[XB_TMO], 1u); break; } } } } while (0)

struct XcdBarrier {
    unsigned* bar; unsigned x;
    volatile LAS unsigned* st;
};

__device__ __forceinline__ XcdBarrier xcd_barrier_post(unsigned* bar, volatile LAS unsigned* st, int tid_b) {
    XcdBarrier b; b.bar = bar; b.x = xb_xcc_id(); b.st = st;
    if (tid_b == 0) (void)xb_add(&bar[XB_XCNT(b.x)], 1u);
    return b;
}
__device__ __forceinline__ void xcd_barrier_complete(unsigned* bar, unsigned x, unsigned& nloc, unsigned& nx) {
    const unsigned G = gridDim.x * gridDim.y * gridDim.z;
    unsigned sum, cnt, mine, sp = 0u;
    for (;;) {
        sum = 0u; cnt = 0u; mine = 0u;
#pragma unroll
        for (unsigned j = 0; j < 16; ++j) { const unsigned c = xb_ld(&bar[XB_XCNT(j)]); sum += c; cnt += (c > 0u) ? 1u : 0u; mine = (j == x) ? c : mine; }
        if (sum == G) break;
        __builtin_amdgcn_s_sleep(1);
        if ((++sp & 255u) == 0u) { if (xb_ld(&bar[XB_TMO])) break; if (sp > XB_SPIN_CAP) { atomicAdd(&bar[XB_TMO], 1u); break; } }
    }
    nloc = mine > 0u ? mine : 1u; nx = cnt > 0u ? cnt : 1u;
}

__device__ __forceinline__ void xcd_barrier(const XcdBarrier& b, int tid_b) {
    asm volatile("s_waitcnt vmcnt(0)" ::: "memory");
    __syncthreads();
    if (tid_b == 0) {
        unsigned* bar = b.bar;
        __builtin_amdgcn_s_waitcnt(0);
        unsigned nloc = b.st[0], nx = b.st[1];
        if (nloc == 0u) { xcd_barrier_complete(bar, b.x, nloc, nx); b.st[0] = nloc; b.st[1] = nx; }
        const unsigned old = xb_add(&bar[XB_XSUB(b.x)], 1u);
        const unsigned gen = old / nloc;
        if (old + 1u == (gen + 1u) * nloc) {
            __builtin_amdgcn_fence(__ATOMIC_RELEASE, "agent");
            asm volatile("s_waitcnt vmcnt(0)" ::: "memory");
            const unsigned og = xb_add(&bar[XB_TOP], 1u);
            const unsigned tg = og / nx;
            if (og + 1u == (tg + 1u) * nx) xb_add(&bar[XB_TOPGEN], 1u);
            else XB_SPIN(xb_ld(&bar[XB_TOPGEN]) == tg, bar);
            __builtin_amdgcn_fence(__ATOMIC_ACQUIRE, "agent");
            xb_add(&bar[XB_XGEN(b.x)], 1u);
            asm volatile("s_waitcnt vmcnt(0)" ::: "memory");
        } else {
            XB_SPIN(xb_ld(&bar[XB_XGEN(b.x)]) == gen, bar);
            __builtin_amdgcn_fence(__ATOMIC_ACQUIRE, "agent");
            asm volatile("s_waitcnt vmcnt(0)" ::: "memory");
        }
    }
    __syncthreads();
}


__device__ __forceinline__ int hw_lane() { int l; asm volatile("v_mbcnt_lo_u32_b32 %0, -1, 0\n\tv_mbcnt_hi_u32_b32 %0, -1, %0" : "=v"(l)); return l; }
__device__ __forceinline__ float bf2f(bf16 u) { return __builtin_bit_cast(float, (unsigned)u << 16); }
__device__ __forceinline__ float wave_sum(float v, int lane) {
    v += sx<1>(v, lane); v += sx<2>(v, lane); v += sx<4>(v, lane); v += sx<8>(v, lane); v += sx<16>(v, lane); v += sx<32>(v, lane);
    return v;
}
__device__ __forceinline__ float sigmoidf_(float x) { return __builtin_amdgcn_rcpf(1.0f + __builtin_amdgcn_exp2f(-1.4426950408889634f * x)); }
__device__ __forceinline__ float block_sum(float v, LAS float* buf, int wave, int lane) {
    v = wave_sum(v, lane); if (lane == 0) buf[wave] = v; __syncthreads();
    float s = 0.f;
#pragma unroll
    for (int i = 0; i < NWAVES; ++i) s += buf[i];
    __syncthreads(); return s;
}

__device__ __forceinline__ void tr_item(const float* W, int ldw, int c0, const float* gs, bf16* WT, int ldk, int drow, LAS float* scr, int k0, int n0, int lane) {
    const float* src = W + (size_t)(k0 + (lane >> 5)) * ldw + c0 + n0 + (lane & 31); float v[32];
    const float g = gs ? gs[k0 + lane] : 1.0f;
#pragma unroll
    for (int i = 0; i < 32; ++i) v[i] = src[(size_t)(2 * i) * ldw];
#pragma unroll
    for (int i = 0; i < 32; ++i) { const float g0 = __builtin_bit_cast(float, __builtin_amdgcn_readlane(__builtin_bit_cast(int, g), 2 * i)), g1 = __builtin_bit_cast(float, __builtin_amdgcn_readlane(__builtin_bit_cast(int, g), 2 * i + 1));
        scr[(2 * i + (lane >> 5)) * 33 + (lane & 31)] = v[i] * (lane < 32 ? g0 : g1); }
    LDS_WAIT(); asm volatile("" ::: "memory");
    const int c = lane & 7;
#pragma unroll
    for (int j = 0; j < 4; ++j) { const int n = (lane >> 3) + 8 * j; const LAS float* s = scr + (8 * c) * 33 + n;
        v4u o; o.x = pk2(s[0 * 33], s[1 * 33]); o.y = pk2(s[2 * 33], s[3 * 33]); o.z = pk2(s[4 * 33], s[5 * 33]); o.w = pk2(s[6 * 33], s[7 * 33]);
        *(GAS v4u*)(WT + (size_t)(drow + n0 + n) * ldk + k0 + 8 * c) = o; }
    LDS_WAIT(); asm volatile("" ::: "memory");
}
typedef const __attribute__((address_space(4))) char* kaptr_t;
__device__ __forceinline__ kaptr_t karg() { kaptr_t p = (kaptr_t)__builtin_amdgcn_kernarg_segment_ptr(); asm volatile("" : "+s"(p)); return p; }
struct Ptrs {
    __device__ __forceinline__ const float* in(int k) const { return *(const float* const __attribute__((address_space(4)))*)(karg() + 8 * k); }
#define PF(name, k) __device__ __forceinline__ const float* name() const { return in(k); }
    PF(x, 0) PF(g_mix, 1) PF(g_ffn, 2) PF(g_fin, 3) PF(ev_w_in, 4) PF(ev_cw, 5) PF(ev_cb, 6) PF(ev_ib, 7) PF(ev_fb, 8) PF(ev_ngm, 9) PF(ev_ngr, 10) PF(ev_w_out, 11)
    PF(od_w_in, 12) PF(od_pw, 13) PF(od_ps, 14) PF(od_dw, 15) PF(od_db, 16) PF(od_ng, 17) PF(od_nb, 18) PF(od_w_out, 19) PF(w_gate, 20) PF(w_up, 21) PF(w_down, 22)
#undef PF
    __device__ __forceinline__ float* out() const { return *(float* const __attribute__((address_space(4)))*)(karg() + 184); }
    __device__ __forceinline__ unsigned char* ws() const { return *(unsigned char* const __attribute__((address_space(4)))*)(karg() + 192); }
    __device__ __forceinline__ int ph_lo() const { return *(const __attribute__((address_space(4))) int*)(karg() + 200); }
    __device__ __forceinline__ int ph_hi() const { return *(const __attribute__((address_space(4))) int*)(karg() + 204); }
};
__device__ __forceinline__ void cv_in(const Ptrs& P, int L, LAS float* scr, int gw, int NGW, int lane) {
    const int j = L >> 1; const bool even = (L & 1) == 0; const float* gm = P.g_mix() + L * D;
    bf16* WIN = (bf16*)(P.ws() + (even ? WS_WIN_A : WS_WIN_B));
    const float* Win = even ? P.ev_w_in() + (size_t)j * D * EV_IN : P.od_w_in() + (size_t)j * D * OD_N;
    const int ldin = even ? EV_IN : OD_N, nblk = even ? 64 : 48, I_INA = 16 * nblk, I_INB = even ? 16 * 64 : 0;
    for (int it = gw; it < I_INA + I_INB; it += NGW) {
        if (it < I_INA) tr_item(Win, ldin, 0, gm, WIN, D, 0, scr, 64 * (it / nblk), 32 * (it % nblk), lane);
        else { const int r = it - I_INA; tr_item(Win, ldin, 2056, gm, WIN, D, 2048, scr, 64 * (r / 64), 32 * (r % 64), lane); } }
    if (even) { bf16* WTG = (bf16*)(P.ws() + WS_WTG);
#pragma clang loop vectorize(disable) unroll(disable)
        for (int idx = gw * 64 + lane; idx < 8 * D; idx += NGW * 64) { const int c = idx >> 10, k = idx & 1023; WTG[idx] = (bf16)f2bf(gm[k] * Win[(size_t)k * EV_IN + 2048 + c]); } }
}
__device__ __forceinline__ void cv_out(const Ptrs& P, int L, LAS float* scr, int gw, int NGW, int lane) {
    const int j = L >> 1; const bool even = (L & 1) == 0;
    const float* Wout = even ? P.ev_w_out() + (size_t)j * D * D : P.od_w_out() + (size_t)j * D * D; bf16* WOUT = (bf16*)(P.ws() + WS_WOUT) + (size_t)L * D * D;
    const int I_OUT = 16 * 32, I_POOL = even ? 0 : 32;
    for (int it = gw; it < I_OUT + I_POOL; it += NGW) {
        if (it < I_OUT) tr_item(Wout, D, 0, nullptr, WOUT, D, 0, scr, 64 * (it / 32), 32 * (it % 32), lane);
        else { const int r = it - I_OUT, g = r >> 3, q = r & 7; tr_item(P.od_pw() + (size_t)(j * 4 + g) * 128 * 128, 128, 0, nullptr, (bf16*)(P.ws() + WS_WTP) + g * 128 * 128, 128, 0, scr, 64 * (q >> 2), 32 * (q & 3), lane); } }
}
__device__ __forceinline__ void cv_ffn(const Ptrs& P, int L, LAS float* scr, int gw, int NGW, int lane) {
    const bool even = (L & 1) == 0; const float* gf = P.g_ffn() + L * D;
    bf16* WGU = (bf16*)(P.ws() + (even ? WS_WGU_A : WS_WGU_B)); bf16* WD = (bf16*)(P.ws() + (even ? WS_WD_A : WS_WD_B));
    const float* Wg = P.w_gate() + (size_t)L * D * DFF; const float* Wu = P.w_up() + (size_t)L * D * DFF; const float* Wd = P.w_down() + (size_t)L * DFF * D;
    const int I_G = 16 * 88, I_D = 44 * 32;
    for (int it = gw; it < 2 * I_G + I_D; it += NGW) {
        if (it < 2 * I_G) { const int up = it >= I_G, r = it - up * I_G, n0 = 32 * (r % 88); tr_item(up ? Wu : Wg, DFF, 0, gf, WGU, D, (n0 >> 7) * 256 + (n0 & 127) + up * 128 - n0, scr, 64 * (r / 88), n0, lane); }
        else { const int r = it - 2 * I_G; tr_item(Wd, D, 0, nullptr, WD, DFF, 0, scr, 64 * (r / 32), 32 * (r % 32), lane); } }
}
__device__ __forceinline__ void prologue_rows(const Ptrs& P, int gw, int NGW, int lane) {
    bf16* XB = (bf16*)(P.ws() + WS_XB); float* SSQ = (float*)(P.ws() + WS_SSQ); float* ROT = (float*)(P.ws() + WS_ROT);
    for (int m = gw; m < M; m += NGW) {
        const GAS f32x4* xr = (const GAS f32x4*)(P.x() + (size_t)m * D) + lane; GAS unsigned long long* o8 = (GAS unsigned long long*)(XB + (size_t)m * D) + lane;
        float s = 0.f;
#pragma unroll
        for (int q = 0; q < 4; ++q) { const f32x4 v = xr[64 * q]; s += (v.x * v.x + v.y * v.y) + (v.z * v.z + v.w * v.w); o8[64 * q] = (unsigned long long)pk2(v.x, v.y) | ((unsigned long long)pk2(v.z, v.w) << 32); }
        s = wave_sum(s, lane);
        if (lane < 16) SSQ[(size_t)m * 16 + lane] = lane == 0 ? s : 0.f;
    }
    for (int t = gw; t < SEQ; t += NGW) {
        const float inv = powf(10000.0f, -(float)(2 * lane) / 128.0f); const float ang = (float)t * inv; float sn, cs; sincosf(ang, &sn, &cs);
        ROT[((size_t)t * 64 + lane) * 2] = cs; ROT[((size_t)t * 64 + lane) * 2 + 1] = sn;
    }
}
__device__ __forceinline__ void final_norm(const Ptrs& P, int gw, int NGW, int lane) {
    const bf16* XBp = (const bf16*)(P.ws() + WS_XB);
    for (int m = gw; m < M; m += NGW) {
        const GAS v4u* xr = (const GAS v4u*)(XBp + (size_t)m * D) + lane; GAS f32x4* orow = (GAS f32x4*)(P.out() + (size_t)m * D); const GAS f32x4* gr = (const GAS f32x4*)P.g_fin();
        float v[16]; float s = 0.f;
#pragma unroll
        for (int q = 0; q < 2; ++q) { const v4u w = xr[64 * q];
#pragma unroll
            for (int e = 0; e < 4; ++e) { v[8 * q + 2 * e] = __builtin_bit_cast(float, w[e] << 16); v[8 * q + 2 * e + 1] = __builtin_bit_cast(float, w[e] & 0xffff0000u); } }
#pragma unroll
        for (int k = 0; k < 16; ++k) s += v[k] * v[k];
        const float rs = __builtin_amdgcn_rsqf(wave_sum(s, lane) * (1.0f / D) + EPS);
#pragma unroll
        for (int q = 0; q < 2; ++q)
#pragma unroll
            for (int hq = 0; hq < 2; ++hq) { const int idx = 2 * (lane + 64 * q) + hq; const f32x4 g = gr[idx];
                orow[idx] = (f32x4){v[8 * q + 4 * hq] * rs * g.x, v[8 * q + 4 * hq + 1] * rs * g.y, v[8 * q + 4 * hq + 2] * rs * g.z, v[8 * q + 4 * hq + 3] * rs * g.w}; }
    }
}
__device__ __forceinline__ void gates_rows(const Ptrs& P, int j, int gw, int NGW, int lane) {
    const bf16* XB = (const bf16*)(P.ws() + WS_XB); const bf16* WTG = (const bf16*)(P.ws() + WS_WTG); const float* SSQ = (const float*)(P.ws() + WS_SSQ); float* GATES = (float*)(P.ws() + WS_GATES);
    const int r16 = lane & 15, kq = lane >> 4; const float bias = r16 < 4 ? P.ev_ib()[j * 4 + r16] : (r16 < 8 ? P.ev_fb()[j * 4 + r16 - 4] : 0.f);
    for (int grp = gw; grp < M / 16; grp += NGW) {
        const GAS v4u* a = (const GAS v4u*)(XB + (size_t)(grp * 16 + r16) * D + 8 * kq); const GAS v4u* w = (const GAS v4u*)(WTG + (size_t)(r16 & 7) * D + 8 * kq);
        pg8::f32x4 acc = (pg8::f32x4){0.f, 0.f, 0.f, 0.f};
#pragma unroll 8
        for (int s2 = 0; s2 < D / 32; ++s2) { const v4u av = a[4 * s2]; v4u wv = w[4 * s2]; if (r16 >= 8) wv = (v4u){0u, 0u, 0u, 0u};
            acc = __builtin_amdgcn_mfma_f32_16x16x32_bf16(__builtin_bit_cast(bf16x8, av), __builtin_bit_cast(bf16x8, wv), acc, 0, 0, 0); }
        const f32x4 p = *(const GAS f32x4*)(SSQ + (size_t)(grp * 16 + r16) * 16 + 4 * kq); float sq = (p.x + p.y) + (p.z + p.w);
        sq += sx<16>(sq, lane); sq += sx<32>(sq, lane);
        const float rs = __builtin_amdgcn_rsqf(sq * (1.0f / D) + EPS);
#pragma unroll
        for (int e = 0; e < 4; ++e) { const float rr = __builtin_bit_cast(float, __builtin_amdgcn_ds_bpermute((4 * kq + e) << 2, __builtin_bit_cast(int, rs)));
            if (r16 < 8) GATES[(size_t)(grp * 16 + 4 * kq + e) * 8 + r16] = acc[e] * rr + bias; }
    }
}

typedef float f32x2v __attribute__((ext_vector_type(2)));
typedef float f32x16 __attribute__((ext_vector_type(16)));
__device__ __forceinline__ f32x2v unpk2(unsigned w) { f32x2v r; r.x = __builtin_bit_cast(float, w << 16); r.y = __builtin_bit_cast(float, w & 0xffff0000u); return r; }
__device__ __forceinline__ int crow(int reg, int h) { return (reg & 3) + 8 * (reg >> 2) + 4 * h; }
template <int N, int DIST> __device__ __forceinline__ void bfly_step(const float (&v)[N], float (&r)[N / 2], int lane) {
    const bool up = (lane & DIST) != 0;
#pragma unroll
    for (int i = 0; i < N / 2; ++i) { const float send = up ? v[i] : v[i + N / 2], keep = up ? v[i + N / 2] : v[i]; r[i] = keep + sx<DIST>(send, lane); }
}
__device__ __forceinline__ float bfly32(const float (&v)[32], int lane) {
    float a[16], b[8], c[4], d[2], e[1];
    bfly_step<32, 32>(v, a, lane); bfly_step<16, 16>(a, b, lane); bfly_step<8, 8>(b, c, lane); bfly_step<4, 4>(c, d, lane); bfly_step<2, 2>(d, e, lane);
    return e[0] + sx<1>(e[0], lane);
}
constexpr int OD_Y_ROWS = 94, OD_U_ROWS = 79, OD_WP_OFF = OD_Y_ROWS * 1024, OD_MS_OFF = OD_WP_OFF + 2048, OD_PL_STRIDE = 1040;
__device__ __forceinline__ void od_fast_item(const Ptrs& P, int j, LAS unsigned char* lds, int item, int tid_in) {
    int tid = tid_in; asm volatile("" : "+v"(tid));
    const bf16* Z = (const bf16*)(P.ws() + WS_Z); bf16* MIXED = (bf16*)(P.ws() + WS_MIXED);
    const int row0 = item * 64, t0 = row0 & (SEQ - 1), lane = tid & 63, wv = tid >> 6;
    const bf16* zt = Z + (size_t)row0 * OD_N;
    for (int idx = tid; idx < OD_Y_ROWS * 64; idx += NWAVES * 64) { const int r = idx >> 6, ch = idx & 63, trel = r - 30; v4u o = (v4u){0u, 0u, 0u, 0u};
        if (t0 + trel >= 0) { const bf16* zr = zt + (long)trel * OD_N + 8 * ch; const v4u ga = *(const GAS v4u*)(zr + 512), gb = *(const GAS v4u*)(zr + 1024);
#pragma unroll
            for (int e = 0; e < 4; ++e) { const f32x2v a = unpk2(ga[e]), b = unpk2(gb[e]); o[e] = pk2(a.x * sigmoidf_(b.x), a.y * sigmoidf_(b.y)); } }
        *(LAS v4u*)(lds + r * 1024 + ch * 16) = o; }
    __syncthreads();
    const int cp = tid & 255, th = tid >> 8;
    f32x2v acc[32];
    {
        const float* dw = P.od_dw() + (size_t)j * 31 * 512 + 2 * cp; f32x2v w[31];
#pragma unroll
        for (int k = 0; k < 31; ++k) w[k] = *(const GAS f32x2v*)(dw + k * 512);
        const f32x2v bias = *(const GAS f32x2v*)(P.od_db() + j * 512 + 2 * cp);
#pragma unroll
        for (int t = 0; t < 32; ++t) acc[t] = bias;
        const LAS unsigned char* yb = lds + (32 * th) * 1024 + 4 * cp;
#pragma unroll
        for (int r = 0; r < 62; ++r) { const f32x2v y = unpk2(*(const LAS unsigned*)(yb + r * 1024));
#pragma unroll
            for (int t = (r > 30 ? r - 30 : 0); t <= (r < 31 ? r : 31); ++t) acc[t] += w[r - t] * y;
            if ((r & 3) == 3) asm volatile("" ::: "memory"); }
    }
    {
        float s1[32], s2[32];
#pragma unroll
        for (int t = 0; t < 32; ++t) { s1[t] = acc[t].x + acc[t].y; s2[t] = acc[t].x * acc[t].x + acc[t].y * acc[t].y; }
        const float t1 = bfly32(s1, lane), t2 = bfly32(s2, lane);
        if ((lane & 1) == 0) *(LAS f32x2v*)(lds + OD_WP_OFF + (wv * 32 + (lane >> 1)) * 8) = (f32x2v){t1, t2};
    }
    __syncthreads();
    if (tid < 64) { const int th_ = tid >> 5, tk = tid & 31; f32x2v a = (f32x2v){0.f, 0.f};
#pragma unroll
        for (int w4 = 0; w4 < 4; ++w4) a += *(const LAS f32x2v*)(lds + OD_WP_OFF + ((th_ * 4 + w4) * 32 + tk) * 8);
        const float mean = a.x * (1.0f / 512.0f), var = fmaxf(a.y * (1.0f / 512.0f) - mean * mean, 0.f);
        *(LAS f32x2v*)(lds + OD_MS_OFF + tid * 8) = (f32x2v){mean, __builtin_amdgcn_rsqf(var + EPS)}; }
    __syncthreads();
    {
        const f32x2v g2 = *(const GAS f32x2v*)(P.od_ng() + j * 512 + 2 * cp), b2 = *(const GAS f32x2v*)(P.od_nb() + j * 512 + 2 * cp);
        bf16* mo = MIXED + (size_t)(row0 + 32 * th) * D + 512 + 2 * cp; const LAS unsigned char* msb = lds + OD_MS_OFF + (32 * th) * 8;
#pragma unroll
        for (int t = 0; t < 32; ++t) { const f32x2v ms = *(const LAS f32x2v*)(msb + t * 8);
            f32x2v y = (acc[t] - ms.x) * ms.y * g2 + b2; y.x *= sigmoidf_(y.x); y.y *= sigmoidf_(y.y);
            *(GAS unsigned*)mo = pk2(y.x, y.y); mo += D; asm volatile("" : "+v"(mo)); }
    }
    for (int idx = tid; idx < OD_U_ROWS * 64; idx += NWAVES * 64) { const int r = idx >> 6, ch = idx & 63, trel = r - 15; v4u o = (v4u){0u, 0u, 0u, 0u};
        if (t0 + trel >= 0) o = *(const GAS v4u*)(zt + (long)trel * OD_N + 8 * ch);
        *(LAS v4u*)(lds + r * 1024 + ch * 16) = o; }
    __syncthreads();
    {
        const int w = 2 << (cp >> 6); f32x2v S = (f32x2v){0.f, 0.f}, pooled[32];
        const LAS unsigned char* pb = lds + (32 * th + 15) * 1024 + 4 * cp; const LAS unsigned char* pwb = pb - w * 1024;
        for (int k = 0; k < w; ++k) S += unpk2(*(const LAS unsigned*)(pb - k * 1024));
#pragma unroll
        for (int t = 0; t < 32; ++t) { const f32x2v cur = unpk2(*(const LAS unsigned*)(pb + t * 1024));
            if (t > 0) S += cur - unpk2(*(const LAS unsigned*)(pwb + t * 1024));
            const int tp1 = t0 + 32 * th + t + 1; const float ic = __builtin_amdgcn_rcpf((float)(tp1 < w ? tp1 : w));
            pooled[t] = S * ic - cur; }
        __syncthreads();
        { LAS unsigned char* plb = lds + (32 * th) * OD_PL_STRIDE + 4 * cp;
#pragma unroll
        for (int t = 0; t < 32; ++t) *(LAS unsigned*)(plb + t * OD_PL_STRIDE) = pk2(pooled[t].x, pooled[t].y); }
    }
    __syncthreads();
    {
        const int g = wv >> 1, tt = wv & 1, r = lane & 31, hh = lane >> 5;
        const bf16* WTP = (const bf16*)(P.ws() + WS_WTP) + (size_t)g * 128 * 128;
        f32x16 c4[4];
#pragma unroll
        for (int ot = 0; ot < 4; ++ot)
#pragma unroll
            for (int i = 0; i < 16; ++i) c4[ot][i] = 0.f;
#pragma unroll
        for (int s = 0; s < 8; ++s) { const bf16x8 a = *(const LAS bf16x8*)(lds + (32 * tt + r) * OD_PL_STRIDE + g * 256 + s * 32 + hh * 16);
#pragma unroll
            for (int ot = 0; ot < 4; ++ot) { const bf16x8 b = *(const GAS bf16x8*)(WTP + (size_t)(32 * ot + r) * 128 + 16 * s + 8 * hh);
                c4[ot] = __builtin_amdgcn_mfma_f32_32x32x16_bf16(a, b, c4[ot], 0, 0, 0); } }
#pragma unroll
        for (int ot = 0; ot < 4; ++ot) { const float ps = P.od_ps()[j * 512 + g * 128 + 32 * ot + r];
#pragma unroll
            for (int i = 0; i < 16; ++i) { bf16* q = MIXED + (size_t)(row0 + 32 * tt + 4 * hh) * D + g * 128 + 32 * ot + r; asm volatile("" : "+v"(q)); q[(size_t)((i & 3) + 8 * (i >> 2)) * D] = (bf16)f2bf(c4[ot][i] * ps); } }
    }
    __syncthreads();
}

typedef short v4i16_t __attribute__((ext_vector_type(4)));
typedef unsigned u32x2 __attribute__((ext_vector_type(2)));
constexpr int EV_Q = 0, EV_K = 32768, EV_VT = 65536, EV_CT = 98304, EV_SC = 132096;
constexpr int SC_G = 0, SC_RF = 512, SC_INT = 1024, SC_EMM = 1536, SC_PAR = 2048, SC_QN = 4096, SC_N = 4608, SC_NP = 5120, SC_SS = 9216;
__device__ __forceinline__ unsigned offb(unsigned row, unsigned ch) { return 256u * row + 16u * (ch ^ (((row & 3u) << 2) | ((row >> 2) & 3u))); }
__device__ __forceinline__ bf16x8 tr_frag(LAS unsigned char* img, int lane, int c, int ks) {
    const unsigned h = lane >> 5, blk = (lane >> 4) & 1, q = (lane & 15) >> 2, p = lane & 3;
    const v4i16_t lo = __builtin_amdgcn_ds_read_tr16_b64_v4i16((LAS v4i16_t*)(img + offb(16 * ks + 8 * h + q, 4 * c + 2 * blk + (p >> 1)) + 8 * (p & 1)));
    const v4i16_t hi = __builtin_amdgcn_ds_read_tr16_b64_v4i16((LAS v4i16_t*)(img + offb(16 * ks + 8 * h + 4 + q, 4 * c + 2 * blk + (p >> 1)) + 8 * (p & 1)));
    return (bf16x8){lo[0], lo[1], lo[2], lo[3], hi[0], hi[1], hi[2], hi[3]};
}
__device__ __forceinline__ void unpk8(const v4u w, float (&o)[8]) {
#pragma unroll
    for (int e = 0; e < 4; ++e) { o[2 * e] = __builtin_bit_cast(float, w[e] << 16); o[2 * e + 1] = __builtin_bit_cast(float, w[e] & 0xffff0000u); }
}
__device__ __forceinline__ v4u pk8(const float (&o)[8]) { v4u w; w.x = pk2(o[0], o[1]); w.y = pk2(o[2], o[3]); w.z = pk2(o[4], o[5]); w.w = pk2(o[6], o[7]); return w; }
__device__ __forceinline__ float siluf_(float x) { return x * sigmoidf_(x); }
constexpr int SC_WL = 9232, SC_NG = SC_WL + 5120;
__device__ __forceinline__ void conv4_silu_pre(const v4u (&raw)[7], const LAS unsigned char* wl, int dc, float (&out)[4][8]) {
    float w[5][8];
#pragma unroll
    for (int tap = 0; tap < 5; ++tap) { const f32x4 a = *(const LAS f32x4*)(wl + (tap * 128 + 8 * dc) * 4), b = *(const LAS f32x4*)(wl + (tap * 128 + 8 * dc + 4) * 4);
        w[tap][0] = a.x; w[tap][1] = a.y; w[tap][2] = a.z; w[tap][3] = a.w; w[tap][4] = b.x; w[tap][5] = b.y; w[tap][6] = b.z; w[tap][7] = b.w; }
#pragma unroll
    for (int jj = 0; jj < 4; ++jj)
#pragma unroll
        for (int e = 0; e < 8; ++e) out[jj][e] = w[4][e];
#pragma unroll
    for (int rr = 0; rr < 7; ++rr) { float x[8]; unpk8(raw[rr], x);
#pragma unroll
        for (int jj = 0; jj < 4; ++jj) { const int tap = rr - jj; if (tap >= 0 && tap < 4) {
#pragma unroll
            for (int e = 0; e < 8; ++e) out[jj][e] += w[tap][e] * x[e]; } } }
#pragma unroll
    for (int jj = 0; jj < 4; ++jj)
#pragma unroll
        for (int e = 0; e < 8; ++e) out[jj][e] = siluf_(out[jj][e]);
}
__device__ __forceinline__ void rot4_pre(const v4u (&raw)[4], const f32x4 (&cs)[16], int dc, int lane, float (&out)[4][8]) {
#pragma unroll
    for (int jj = 0; jj < 4; ++jj) { v4u pr; pr.x = sxu<8>(raw[jj].x, lane); pr.y = sxu<8>(raw[jj].y, lane); pr.z = sxu<8>(raw[jj].z, lane); pr.w = sxu<8>(raw[jj].w, lane);
        float x[8], xp[8]; unpk8(raw[jj], x); unpk8(pr, xp);
#pragma unroll
        for (int e2 = 0; e2 < 4; ++e2) { const f32x4 c4 = cs[4 * jj + e2];
            out[jj][2 * e2] = dc < 8 ? x[2 * e2] * c4.x - xp[2 * e2] * c4.y : xp[2 * e2] * c4.y + x[2 * e2] * c4.x;
            out[jj][2 * e2 + 1] = dc < 8 ? x[2 * e2 + 1] * c4.z - xp[2 * e2 + 1] * c4.w : xp[2 * e2 + 1] * c4.w + x[2 * e2 + 1] * c4.z; } }
}
template <bool RET>
__device__ __forceinline__ void ev_fast_item(const Ptrs& P, int jl, LAS unsigned char* lds, int item, int tid_in) {
    int tid0 = tid_in; asm volatile("" : "+v"(tid0));
    const bf16* Z = (const bf16*)(P.ws() + WS_Z);
    const int b = (item >> 2) & 7, h = item & 3;
    LAS unsigned char* sc = lds + EV_SC;
    constexpr int NRAW = RET ? 4 : 7;
    constexpr int COL_K = RET ? 2560 : 512, COL_Q = RET ? 2048 : 0, COL_V = RET ? 3072 : 1024, COL_G = RET ? 3584 : 1536;
    for (int k = tid0 * 16; k < 32768; k += NWAVES * 64 * 16) *(LAS v4u*)(lds + EV_CT + k) = (v4u){0u, 0u, 0u, 0u};
    if (tid0 < 128) { *(LAS float*)(sc + SC_N + 4 * tid0) = 0.f; *(LAS float*)(sc + SC_NG + 4 * tid0) = (RET ? P.ev_ngr() : P.ev_ngm())[jl * 512 + h * 128 + tid0]; }
    if (!RET && tid0 < 256) { const int isq = tid0 >> 7, d = tid0 & 127, ch = (isq ? 512 : 0) + h * 128 + d; const float* cw = P.ev_cw() + (size_t)jl * 4096;
#pragma unroll
        for (int tap = 0; tap < 4; ++tap) *(LAS float*)(sc + SC_WL + ((isq * 5 + tap) * 128 + d) * 4) = cw[tap * 1024 + ch];
        *(LAS float*)(sc + SC_WL + ((isq * 5 + 4) * 128 + d) * 4) = P.ev_cb()[jl * 1024 + ch]; }
    if (RET && tid0 < 128) { const float lg = __logf(1.0f - exp2f(-5.0f - (float)h));
#pragma unroll
        for (int p = 0; p < 2; ++p) { LAS unsigned char* s = sc + p * SC_PAR;
            *(LAS float*)(s + SC_G + 4 * tid0) = __expf(lg * (float)(127 - tid0)); *(LAS float*)(s + SC_RF + 4 * tid0) = __expf(lg * (float)(tid0 - 127));
            *(LAS float*)(s + SC_INT + 4 * tid0) = __expf(lg * (float)(tid0 + 1));
            if (tid0 == 0) { float one = 1.0f; asm volatile("" : "+v"(one)); *(LAS float*)(sc + SC_SS + 8 * p) = __expf(lg * 128.0f); *(LAS float*)(sc + SC_SS + 8 * p + 4) = one; } } }
    f32x16 Cst[2];
#pragma unroll
    for (int t = 0; t < 2; ++t)
#pragma unroll
        for (int i = 0; i < 16; ++i) Cst[t][i] = 0.f;
    v4u pk[NRAW], pq[NRAW], pv[4]; float gpre[4] = {0.f, 0.f, 0.f, 0.f};
    float m_prev = -1e30f;
    const float* GATES = (const float*)(P.ws() + WS_GATES);
#define EV_LD(ub, voff) (*(const GAS v4u*)((const GAS char*)(ub) + (size_t)(unsigned)(voff)))
#define EV_PREFETCH(cc) do { const int jg_ = tid0 >> 4, dc_ = tid0 & 15, j0_ = 4 * jg_; const unsigned voff_ = (unsigned)(j0_ * EV_N + 8 * dc_) * 2u; \
        const bf16* zu = Z + ((size_t)b * SEQ + (size_t)(cc) * CHUNK) * EV_N + h * 128;     \
        if constexpr (!RET) { _Pragma("unroll") for (int rr = 0; rr < 7; ++rr) { \
                if ((cc) == 0 && j0_ - 3 + rr < 0) { pk[rr] = (v4u){0u, 0u, 0u, 0u}; pq[rr] = (v4u){0u, 0u, 0u, 0u}; } else { pk[rr] = EV_LD(zu + (long)(rr - 3) * EV_N + COL_K, voff_); pq[rr] = EV_LD(zu + (long)(rr - 3) * EV_N + COL_Q, voff_); } } } \
        else { _Pragma("unroll") for (int jj = 0; jj < 4; ++jj) { pk[jj] = EV_LD(zu + (long)jj * EV_N + COL_K, voff_); pq[jj] = EV_LD(zu + (long)jj * EV_N + COL_Q, voff_); } } \
        _Pragma("unroll") for (int jj = 0; jj < 4; ++jj) pv[jj] = EV_LD(zu + (long)jj * EV_N + COL_V, voff_); } while (0)
#define EV_GATES_PREFETCH(cc) do { const float* gp = GATES + ((size_t)b * SEQ + (size_t)(cc) * CHUNK + 2 * (tid0 & 63)) * 8; gpre[0] = gp[h]; gpre[1] = gp[4 + h]; gpre[2] = gp[8 + h]; gpre[3] = gp[12 + h]; } while (0)
#define EV_STEP0(cc) do { const int lane_ = tid0 & 63; LAS unsigned char* sq = sc + ((cc) & 1) * SC_PAR; \
        const float ip0 = gpre[0], fp0 = gpre[1], ip1 = gpre[2], fp1 = gpre[3]; \
        const float lf0 = fminf(fp0, 0.f) - log1pf(__expf(-fabsf(fp0))), lf1 = fminf(fp1, 0.f) - log1pf(__expf(-fabsf(fp1))); \
        const float c1 = lf0 + lf1; float tot = c1; \
        _Pragma("unroll") for (int o = 1; o < 64; o <<= 1) { const float t = shup(tot, o, lane_); if (lane_ >= o) tot += t; } \
        const float ex = tot - c1, b0 = ex + lf0, b1 = ex + c1; \
        const float a0 = ip0 - b0, a1 = ip1 - b1; float pm = fmaxf(a0, a1); \
        _Pragma("unroll") for (int o = 1; o < 64; o <<= 1) { const float t = shup(pm, o, lane_); if (lane_ >= o) pm = fmaxf(pm, t); } \
        float exm = shup(pm, 1, lane_); if (lane_ == 0) exm = -3.0e38f; \
        const float mu0 = fmaxf(exm, a0), mu1 = pm; \
        const float mu127 = __builtin_bit_cast(float, __builtin_amdgcn_readlane(__builtin_bit_cast(int, pm), 63)), total = __builtin_bit_cast(float, __builtin_amdgcn_readlane(__builtin_bit_cast(int, tot), 63)); \
        const float m0 = fmaxf(b0 + mu0, b0 + m_prev), m1 = fmaxf(b1 + mu1, b1 + m_prev); \
        *(LAS f32x2v*)(sq + SC_G + 8 * lane_) = (f32x2v){__expf(a0 - mu127), __expf(a1 - mu127)}; \
        *(LAS f32x2v*)(sq + SC_RF + 8 * lane_) = (f32x2v){__expf(b0 + mu127 - m0), __expf(b1 + mu127 - m1)}; \
        *(LAS f32x2v*)(sq + SC_INT + 8 * lane_) = (f32x2v){__expf(b0 + m_prev - m0), __expf(b1 + m_prev - m1)}; \
        *(LAS f32x2v*)(sq + SC_EMM + 8 * lane_) = (f32x2v){__expf(-m0), __expf(-m1)}; \
        const float m_loc = total + mu127, m_new = fmaxf(total + m_prev, m_loc); \
        if (lane_ == 0) { *(LAS float*)(sc + SC_SS + 8 * ((cc) & 1)) = __expf(total + m_prev - m_new); *(LAS float*)(sc + SC_SS + 8 * ((cc) & 1) + 4) = __expf(m_loc - m_new); } \
        m_prev = m_new; } while (0)
    const int wv0 = __builtin_amdgcn_readfirstlane(tid0 >> 6);
    EV_PREFETCH(0);
    if (!RET && wv0 == 1) { EV_GATES_PREFETCH(0); EV_STEP0(0); EV_GATES_PREFETCH(1); }
    __syncthreads();
    for (int c = 0; c < SEQ / CHUNK; ++c) {
        int tid = tid0; asm volatile("" : "+v"(tid));
        const int lane = tid & 63, wv = __builtin_amdgcn_readfirstlane(tid >> 6), r = lane & 31, hh = lane >> 5;
        const int par = c & 1; LAS unsigned char* scp = sc + par * SC_PAR;
        const size_t rowbase = (size_t)b * SEQ + (size_t)c * CHUNK; const bf16* zc = Z + rowbase * EV_N;
        {
            const int jg = tid >> 4, dc = tid & 15, j0 = 4 * jg; float o4[4][8];
            const f32x4 gj = *(const LAS f32x4*)(scp + SC_G + 16 * jg);
            f32x4 prot[RET ? 16 : 1];
            if constexpr (RET) { const float* rp = (const float*)(P.ws() + WS_ROT) + ((size_t)(c * CHUNK + j0) * 64 + 8 * (dc & 7)) * 2;
#pragma unroll
                for (int jj = 0; jj < 4; ++jj)
#pragma unroll
                    for (int e2 = 0; e2 < 4; ++e2) prot[4 * jj + e2] = *(const GAS f32x4*)(rp + jj * 128 + 4 * e2); }
            if constexpr (!RET) conv4_silu_pre(pk, sc + SC_WL + 5 * 128 * 4, dc, o4); else rot4_pre(pk, prot, dc, lane, o4);
            float ns[8];
#pragma unroll
            for (int e = 0; e < 8; ++e) ns[e] = 0.f;
#pragma unroll
            for (int jj = 0; jj < 4; ++jj) { const float gs = KSCALE * gj[jj];
#pragma unroll
                for (int e = 0; e < 8; ++e) { o4[jj][e] *= gs; ns[e] += o4[jj][e]; }
                *(LAS v4u*)(lds + EV_K + offb(j0 + jj, dc)) = pk8(o4[jj]); }
            if constexpr (!RET) {
#pragma unroll
                for (int e = 0; e < 8; ++e) { ns[e] += sx<16>(ns[e], lane); ns[e] += sx<32>(ns[e], lane); }
                if (lane < 16) { *(LAS f32x4*)(sc + SC_NP + wv * 512 + 32 * dc) = (f32x4){ns[0], ns[1], ns[2], ns[3]}; *(LAS f32x4*)(sc + SC_NP + wv * 512 + 32 * dc + 16) = (f32x4){ns[4], ns[5], ns[6], ns[7]}; }
            }
            if constexpr (!RET) conv4_silu_pre(pq, sc + SC_WL, dc, o4); else rot4_pre(pq, prot, dc, lane, o4);
#pragma unroll
            for (int jj = 0; jj < 4; ++jj) *(LAS v4u*)(lds + EV_Q + offb(j0 + jj, dc)) = pk8(o4[jj]);
#pragma unroll
            for (int e = 0; e < 8; ++e) { unsigned short v4[4];
#pragma unroll
                for (int jj = 0; jj < 4; ++jj) v4[jj] = (unsigned short)((e & 1) ? (pv[jj][e >> 1] >> 16) : (pv[jj][e >> 1] & 0xffffu));
                u32x2 w2; w2.x = (unsigned)v4[0] | ((unsigned)v4[1] << 16); w2.y = (unsigned)v4[2] | ((unsigned)v4[3] << 16);
                *(LAS u32x2*)(lds + EV_VT + offb(8 * dc + e, jg >> 1) + 8 * (jg & 1)) = w2; }
        }
        __syncthreads();
        const int it = wv >> 1, sub = (wv & 1) * 2;
        const float s_old = *(const LAS float*)(sc + SC_SS + 8 * par), s_new = *(const LAS float*)(sc + SC_SS + 8 * par + 4);
        f32x16 Pt[2], Ot[2];
        {
            const float rfi = *(const LAS float*)(scp + SC_RF + 4 * (32 * it + r));
#pragma unroll
            for (int t = 0; t < 2; ++t) { const int jt = sub + t;
#pragma unroll
                for (int i = 0; i < 16; ++i) Pt[t][i] = 0.f;
                if (jt <= it) {
#pragma unroll
                    for (int s = 0; s < 8; ++s) { const bf16x8 a = *(const LAS bf16x8*)(lds + EV_K + offb(32 * jt + r, 2 * s + hh)), bq = *(const LAS bf16x8*)(lds + EV_Q + offb(32 * it + r, 2 * s + hh));
                        Pt[t] = __builtin_amdgcn_mfma_f32_32x32x16_bf16(a, bq, Pt[t], 0, 0, 0); }
#pragma unroll
                    for (int i = 0; i < 16; ++i) { float v = Pt[t][i] * rfi; if (jt == it && crow(i, hh) > r) v = 0.f; Pt[t][i] = v; }
                } }
        }
        if (!RET && wv == 1 && c + 1 < SEQ / CHUNK) { EV_STEP0(c + 1); if (c + 2 < SEQ / CHUNK) EV_GATES_PREFETCH(c + 2); }
        if constexpr (!RET) {
            const int i = tid >> 2, part = tid & 3; float a = 0.f;
#pragma unroll
            for (int cc = 0; cc < 4; ++cc) { float q8[8]; unpk8(*(const LAS v4u*)(lds + EV_Q + offb(i, 4 * part + cc)), q8);
                const f32x4 n0 = *(const LAS f32x4*)(sc + SC_N + 4 * (32 * part + 8 * cc)), n1 = *(const LAS f32x4*)(sc + SC_N + 4 * (32 * part + 8 * cc + 4));
                a += q8[0] * n0.x + q8[1] * n0.y + q8[2] * n0.z + q8[3] * n0.w + q8[4] * n1.x + q8[5] * n1.y + q8[6] * n1.z + q8[7] * n1.w; }
            a += sx<1>(a, lane); a += sx<2>(a, lane);
            if (part == 0) *(LAS float*)(sc + SC_QN + 4 * i) = a;
        }
        {
#pragma unroll
            for (int t = 0; t < 2; ++t) { const int dt = sub + t, vt = it; f32x16 kv;
#pragma unroll
                for (int i = 0; i < 16; ++i) kv[i] = 0.f;
#pragma unroll
                for (int s = 0; s < 8; ++s) { const bf16x8 a = tr_frag(lds + EV_K, lane, dt, s), bv = *(const LAS bf16x8*)(lds + EV_VT + offb(32 * vt + r, 2 * s + hh));
                    kv = __builtin_amdgcn_mfma_f32_32x32x16_bf16(a, bv, kv, 0, 0, 0); }
                const int vt2 = sub + t; f32x16 o;
#pragma unroll
                for (int i = 0; i < 16; ++i) o[i] = 0.f;
#pragma unroll
                for (int s = 0; s < 8; ++s) { const bf16x8 a = *(const LAS bf16x8*)(lds + EV_CT + offb(32 * vt2 + r, 2 * s + hh)), bq = *(const LAS bf16x8*)(lds + EV_Q + offb(32 * it + r, 2 * s + hh));
                    o = __builtin_amdgcn_mfma_f32_32x32x16_bf16(a, bq, o, 0, 0, 0); }
                const float inter = *(const LAS float*)(scp + SC_INT + 4 * (32 * it + r));
#pragma unroll
                for (int i = 0; i < 16; ++i) { Ot[t][i] = o[i] * inter; Cst[t][i] = s_old * Cst[t][i] + s_new * kv[i]; } }
        }
        __syncthreads();
        {
#pragma unroll
            for (int t = 0; t < 2; ++t) { const int jt = sub + t;
                if (jt <= it) {
#pragma unroll
                    for (int q = 0; q < 4; ++q) { u32x2 w2; w2.x = pk2(Pt[t][4 * q], Pt[t][4 * q + 1]); w2.y = pk2(Pt[t][4 * q + 2], Pt[t][4 * q + 3]);
                        *(LAS u32x2*)(lds + EV_K + offb(32 * it + r, 4 * jt + q) + 8 * hh) = w2; } }
                const int dt = sub + t, vt = it;
#pragma unroll
                for (int q = 0; q < 4; ++q) { u32x2 w2; w2.x = pk2(Cst[t][4 * q], Cst[t][4 * q + 1]); w2.y = pk2(Cst[t][4 * q + 2], Cst[t][4 * q + 3]);
                    *(LAS u32x2*)(lds + EV_CT + offb(32 * vt + r, 4 * dt + q) + 8 * hh) = w2; } }
            if (!RET && tid < 128) { float a = 0.f;
#pragma unroll
                for (int w = 0; w < NWAVES; ++w) a += *(const LAS float*)(sc + SC_NP + w * 512 + 4 * tid);
                LAS float* np = (LAS float*)(sc + SC_N + 4 * tid); *np = s_old * *np + s_new * a; }
        }
        __syncthreads();
        const int ei = tid >> 2, epart = tid & 3;
        const bf16* zrow = zc + (size_t)ei * EV_N + COL_G + h * 128 + 32 * epart;
        v4u og[4];
#pragma unroll
        for (int cc = 0; cc < 4; ++cc) og[cc] = *(const GAS v4u*)(zrow + 8 * cc);
        {
#pragma unroll
            for (int t = 0; t < 2; ++t) { const int vt2 = sub + t;
                for (int s = 0; s < 2 * (it + 1); ++s) { const bf16x8 a = *(const LAS bf16x8*)(lds + EV_VT + offb(32 * vt2 + r, 2 * s + hh)), bp = *(const LAS bf16x8*)(lds + EV_K + offb(32 * it + r, 2 * s + hh));
                    Ot[t] = __builtin_amdgcn_mfma_f32_32x32x16_bf16(a, bp, Ot[t], 0, 0, 0); }
#pragma unroll
                for (int q = 0; q < 4; ++q) { u32x2 w2; w2.x = pk2(Ot[t][4 * q], Ot[t][4 * q + 1]); w2.y = pk2(Ot[t][4 * q + 2], Ot[t][4 * q + 3]);
                    *(LAS u32x2*)(lds + EV_Q + offb(32 * it + r, 4 * vt2 + q) + 8 * hh) = w2; } }
        }
        __syncthreads();
        float gate[32];
#pragma unroll
        for (int cc = 0; cc < 4; ++cc) { float o8[8]; unpk8(og[cc], o8);
#pragma unroll
            for (int e = 0; e < 8; ++e) gate[8 * cc + e] = RET ? siluf_(o8[e]) : sigmoidf_(o8[e]); }
        { const int cn = c + 1 < SEQ / CHUNK ? c + 1 : c; EV_PREFETCH(cn); }
        {
            const int i = ei, part = epart; float x[32];
#pragma unroll
            for (int cc = 0; cc < 4; ++cc) { float t8[8]; unpk8(*(const LAS v4u*)(lds + EV_Q + offb(i, 4 * part + cc)), t8);
#pragma unroll
                for (int e = 0; e < 8; ++e) x[8 * cc + e] = t8[e]; }
            if constexpr (!RET) {
                float ps = 0.f;
#pragma unroll
                for (int cc = 0; cc < 4; ++cc) { float t8[8]; unpk8(*(const LAS v4u*)(lds + EV_K + offb(i, 4 * part + cc)), t8);
                    ps += ((t8[0] + t8[1]) + (t8[2] + t8[3])) + ((t8[4] + t8[5]) + (t8[6] + t8[7])); }
                ps = part <= (i >> 5) ? ps : 0.f;
                ps += sx<1>(ps, lane); ps += sx<2>(ps, lane);
                const float den = ps + *(const LAS float*)(scp + SC_INT + 4 * i) * *(const LAS float*)(sc + SC_QN + 4 * i);
                const float inv = __builtin_amdgcn_rcpf(fmaxf(fabsf(den), *(const LAS float*)(scp + SC_EMM + 4 * i)));
#pragma unroll
                for (int k = 0; k < 32; ++k) x[k] *= inv * gate[k];
            }
            float s = 0.f;
#pragma unroll
            for (int k = 0; k < 32; ++k) s += x[k];
            s += sx<1>(s, lane); s += sx<2>(s, lane);
            const float mean = s * (1.0f / 128.0f); float q = 0.f;
#pragma unroll
            for (int k = 0; k < 32; ++k) { x[k] -= mean; q += x[k] * x[k]; }
            q += sx<1>(q, lane); q += sx<2>(q, lane);
            const float rstd = __builtin_amdgcn_rsqf(q * (1.0f / 128.0f) + EPS);
            bf16* mo = (bf16*)(P.ws() + WS_MIXED) + (rowbase + i) * D + (RET ? 512 : 0) + h * 128 + 32 * part;
#pragma unroll
            for (int cc = 0; cc < 4; ++cc) { const f32x4 g0 = *(const LAS f32x4*)(sc + SC_NG + 4 * (32 * part + 8 * cc)), g1 = *(const LAS f32x4*)(sc + SC_NG + 4 * (32 * part + 8 * cc + 4)); float y[8];
                y[0] = x[8 * cc] * rstd * g0.x; y[1] = x[8 * cc + 1] * rstd * g0.y; y[2] = x[8 * cc + 2] * rstd * g0.z; y[3] = x[8 * cc + 3] * rstd * g0.w;
                y[4] = x[8 * cc + 4] * rstd * g1.x; y[5] = x[8 * cc + 5] * rstd * g1.y; y[6] = x[8 * cc + 6] * rstd * g1.z; y[7] = x[8 * cc + 7] * rstd * g1.w;
                if constexpr (RET) {
#pragma unroll
                    for (int e = 0; e < 8; ++e) y[e] *= gate[8 * cc + e]; }
                *(GAS v4u*)(mo + 8 * cc) = pk8(y); }
        }
        __syncthreads();
    }
#undef EV_PREFETCH
#undef EV_LD
#undef EV_GATES_PREFETCH
#undef EV_STEP0
}

constexpr size_t WS_NC = WS_SSQ, WS_SCAL = WS_SSQ + 524288, WS_MPREV = WS_SCAL + 8192;
struct G4 { float a, b, c, d; int h; __device__ __forceinline__ float operator[](int k) const { const int q = (k - h) >> 2; return q == 0 ? a : (q == 1 ? b : (q == 2 ? c : d)); } };
#define EV_SCALARS(FULL, gp_, mprev_, lane_, sq, mloc, tot_out) do { \
        const float ip0 = (gp_)[h], fp0 = (gp_)[4 + h], ip1 = (gp_)[8 + h], fp1 = (gp_)[12 + h]; \
        const float lf0 = fminf(fp0, 0.f) - log1pf(__expf(-fabsf(fp0))), lf1 = fminf(fp1, 0.f) - log1pf(__expf(-fabsf(fp1))); \
        const float c1 = lf0 + lf1; float csum_ = c1; \
        _Pragma("unroll") for (int o = 1; o < 64; o <<= 1) { const float t = shup(csum_, o, lane_); if (lane_ >= o) csum_ += t; } \
        const float ex = csum_ - c1, b0 = ex + lf0, b1 = ex + c1; \
        const float a0 = ip0 - b0, a1 = ip1 - b1; float pm = fmaxf(a0, a1); \
        _Pragma("unroll") for (int o = 1; o < 64; o <<= 1) { const float t = shup(pm, o, lane_); if (lane_ >= o) pm = fmaxf(pm, t); } \
        float exm = shup(pm, 1, lane_); if (lane_ == 0) exm = -3.0e38f; \
        const float mu0 = fmaxf(exm, a0), mu1 = pm; \
        const float mu127 = __builtin_bit_cast(float, __builtin_amdgcn_readlane(__builtin_bit_cast(int, pm), 63)), total = __builtin_bit_cast(float, __builtin_amdgcn_readlane(__builtin_bit_cast(int, csum_), 63)); \
        *(LAS f32x2v*)((sq) + SC_G + 8 * lane_) = (f32x2v){__expf(a0 - mu127), __expf(a1 - mu127)}; \
        if (FULL) { const float m0 = fmaxf(b0 + mu0, b0 + (mprev_)), m1 = fmaxf(b1 + mu1, b1 + (mprev_)); \
            *(LAS f32x2v*)((sq) + SC_RF + 8 * lane_) = (f32x2v){__expf(b0 + mu127 - m0), __expf(b1 + mu127 - m1)}; \
            *(LAS f32x2v*)((sq) + SC_INT + 8 * lane_) = (f32x2v){__expf(b0 + (mprev_) - m0), __expf(b1 + (mprev_) - m1)}; \
            *(LAS f32x2v*)((sq) + SC_EMM + 8 * lane_) = (f32x2v){__expf(-m0), __expf(-m1)}; } \
        mloc = total + mu127; tot_out = total; } while (0)
template <bool RET>
__device__ __forceinline__ void ev_p1_item(const Ptrs& P, int jl, LAS unsigned char* lds, int item, int tid_in) {
    int tid = tid_in; asm volatile("" : "+v"(tid));
    const bf16* Z = (const bf16*)(P.ws() + WS_Z);
    const int hi = item >> 4, c = item & 15, b = (hi >> 2) & 7, h = hi & 3;
    const int lane = tid & 63, wv = __builtin_amdgcn_readfirstlane(tid >> 6), r = lane & 31, hh = lane >> 5;
    LAS unsigned char* sc = lds + EV_SC;
    constexpr int NRAW = RET ? 4 : 7; constexpr int COL_K = RET ? 2560 : 512, COL_V = RET ? 3072 : 1024;
    const size_t rowbase = (size_t)b * SEQ + (size_t)c * CHUNK;
    const int jg = tid >> 4, dc = tid & 15, j0 = 4 * jg; const unsigned voff = (unsigned)(j0 * EV_N + 8 * dc) * 2u;
    const bf16* zu = Z + rowbase * EV_N + h * 128;
#define EV_LD(ub, vo) (*(const GAS v4u*)((const GAS char*)(ub) + (size_t)(unsigned)(vo)))
    G4 gq{0.f, 0.f, 0.f, 0.f, h};
    if constexpr (!RET) { if (wv == 0) { const float* gp = (const float*)(P.ws() + WS_GATES) + (rowbase + 2 * lane) * 8; gq.a = gp[h]; gq.b = gp[4 + h]; gq.c = gp[8 + h]; gq.d = gp[12 + h]; } }
    v4u pk[NRAW], pv[4];
    if constexpr (!RET) {
#pragma unroll
        for (int rr = 0; rr < 7; ++rr) { if (c == 0 && j0 - 3 + rr < 0) pk[rr] = (v4u){0u, 0u, 0u, 0u}; else pk[rr] = EV_LD(zu + (long)(rr - 3) * EV_N + COL_K, voff); }
    } else {
#pragma unroll
        for (int jj = 0; jj < 4; ++jj) pk[jj] = EV_LD(zu + (long)jj * EV_N + COL_K, voff);
    }
#pragma unroll
    for (int jj = 0; jj < 4; ++jj) pv[jj] = EV_LD(zu + (long)jj * EV_N + COL_V, voff);
    if constexpr (!RET) {
        if (wv == 0) { float mloc, tot; EV_SCALARS(false, gq, 0.f, lane, sc, mloc, tot);
            if (lane == 0) { float* sp = (float*)(P.ws() + WS_SCAL) + 2 * item; sp[0] = mloc; sp[1] = tot; } }
        if (tid >= 256) { const int d = tid & 127, ch = 512 + h * 128 + d; const float* cw = P.ev_cw() + (size_t)jl * 4096;
#pragma unroll
            for (int tap = 0; tap < 4; ++tap) *(LAS float*)(sc + SC_WL + ((5 + tap) * 128 + d) * 4) = cw[tap * 1024 + ch];
            *(LAS float*)(sc + SC_WL + ((5 + 4) * 128 + d) * 4) = P.ev_cb()[jl * 1024 + ch]; }
    } else if (tid < 128) { const float lg = __logf(1.0f - exp2f(-5.0f - (float)h)); *(LAS float*)(sc + SC_G + 4 * tid) = __expf(lg * (float)(127 - tid)); }
    __syncthreads();
    {
        float o4[4][8]; const f32x4 gj = *(const LAS f32x4*)(sc + SC_G + 16 * jg);
        f32x4 prot[RET ? 16 : 1];
        if constexpr (RET) { const float* rp = (const float*)(P.ws() + WS_ROT) + ((size_t)(c * CHUNK + j0) * 64 + 8 * (dc & 7)) * 2;
#pragma unroll
            for (int jj = 0; jj < 4; ++jj)
#pragma unroll
                for (int e2 = 0; e2 < 4; ++e2) prot[4 * jj + e2] = *(const GAS f32x4*)(rp + jj * 128 + 4 * e2); }
        if constexpr (!RET) conv4_silu_pre(pk, sc + SC_WL + 5 * 128 * 4, dc, o4); else rot4_pre(pk, prot, dc, lane, o4);
        float ns[8];
#pragma unroll
        for (int e = 0; e < 8; ++e) ns[e] = 0.f;
#pragma unroll
        for (int jj = 0; jj < 4; ++jj) { const float gs = KSCALE * gj[jj];
#pragma unroll
            for (int e = 0; e < 8; ++e) { o4[jj][e] *= gs; ns[e] += o4[jj][e]; }
            *(LAS v4u*)(lds + EV_K + offb(j0 + jj, dc)) = pk8(o4[jj]); }
        if constexpr (!RET) {
#pragma unroll
            for (int e = 0; e < 8; ++e) { ns[e] += sx<16>(ns[e], lane); ns[e] += sx<32>(ns[e], lane); }
            if (lane < 16) { *(LAS f32x4*)(sc + SC_NP + wv * 512 + 32 * dc) = (f32x4){ns[0], ns[1], ns[2], ns[3]}; *(LAS f32x4*)(sc + SC_NP + wv * 512 + 32 * dc + 16) = (f32x4){ns[4], ns[5], ns[6], ns[7]}; }
        }
#pragma unroll
        for (int jj = 0; jj < 4; ++jj) *(LAS v4u*)(lds + EV_VT + offb(j0 + jj, dc)) = pv[jj];
    }
    __syncthreads();
    {
        const int it = wv >> 1, sub = (wv & 1) * 2;
#pragma unroll
        for (int t = 0; t < 2; ++t) { const int dt = sub + t, vt = it; f32x16 kv;
#pragma unroll
            for (int i = 0; i < 16; ++i) kv[i] = 0.f;
#pragma unroll
            for (int s = 0; s < 8; ++s) { const bf16x8 a = tr_frag(lds + EV_K, lane, dt, s), bv = tr_frag(lds + EV_VT, lane, vt, s);
                kv = __builtin_amdgcn_mfma_f32_32x32x16_bf16(a, bv, kv, 0, 0, 0); }
#pragma unroll
            for (int q = 0; q < 4; ++q) { u32x2 w2; w2.x = pk2(kv[4 * q], kv[4 * q + 1]); w2.y = pk2(kv[4 * q + 2], kv[4 * q + 3]);
                *(LAS u32x2*)(lds + EV_CT + offb(32 * vt + r, 4 * dt + q) + 8 * hh) = w2; } }
        if (!RET && tid < 128) { float a = 0.f;
#pragma unroll
            for (int w = 0; w < NWAVES; ++w) a += *(const LAS float*)(sc + SC_NP + w * 512 + 4 * tid);
            ((float*)(P.ws() + WS_NC))[(size_t)item * 128 + tid] = a; }
    }
    __syncthreads();
    { unsigned char* dst = (unsigned char*)P.out() + (size_t)item * 32768 + 16 * tid;
#pragma unroll
      for (int k = 0; k < 4; ++k) *(GAS v4u*)(dst + k * 8192) = *(const LAS v4u*)(lds + EV_CT + 16 * tid + k * 8192); }
    __syncthreads();
#undef EV_LD
}
__device__ __forceinline__ void ev_p2_scan(const Ptrs& P, int gtid, int NT) {
    unsigned char* KV = (unsigned char*)P.out(); float* NC = (float*)(P.ws() + WS_NC); const float* SCAL = (const float*)(P.ws() + WS_SCAL); float* MPREV = (float*)(P.ws() + WS_MPREV);
    for (int v = gtid; v < 64 * 2048 + 32 * 128; v += NT) {
        const bool isn = v >= 64 * 2048; const int hi = isn ? (v - 64 * 2048) >> 7 : v >> 11, e = isn ? (v - 64 * 2048) & 127 : v & 2047;
        const bool ret = hi >= 32; const float gam = __expf(128.0f * __logf(1.0f - exp2f(-5.0f - (float)(hi & 3))));
        v4u xs[16]; float xn[16]; f32x2v ms[16];
#pragma unroll
        for (int c = 0; c < 16; ++c) { const int item = hi * 16 + c;
            if (isn) xn[c] = NC[(size_t)item * 128 + e]; else xs[c] = *(const GAS v4u*)(KV + (size_t)item * 32768 + 16 * e);
            ms[c] = ret ? (f32x2v){0.f, 0.f} : *(const GAS f32x2v*)(SCAL + 2 * item); }
        float C[8];
#pragma unroll
        for (int k = 0; k < 8; ++k) C[k] = 0.f;
        float m = -1e30f;
#pragma unroll
        for (int c = 0; c < 16; ++c) { const int item = hi * 16 + c; float so = gam, sn = 1.0f;
            if (!ret) { const float mloc = ms[c].x, tot = ms[c].y; const float mn = fmaxf(tot + m, mloc); so = __expf(tot + m - mn); sn = __expf(mloc - mn);
                if (!isn && e == 0) MPREV[item] = m; m = mn; }
            if (isn) { NC[(size_t)item * 128 + e] = C[0]; C[0] = so * C[0] + sn * xn[c]; }
            else { float x[8]; unpk8(xs[c], x); *(GAS v4u*)(KV + (size_t)item * 32768 + 16 * e) = pk8(C);
#pragma unroll
                for (int k = 0; k < 8; ++k) C[k] = so * C[k] + sn * x[k]; } }
    }
}
template <bool RET>
__device__ __forceinline__ void ev_p3_item(const Ptrs& P, int jl, LAS unsigned char* lds, int item, int tid_in) {
    int tid = tid_in; asm volatile("" : "+v"(tid));
    const bf16* Z = (const bf16*)(P.ws() + WS_Z);
    const int hi = item >> 4, c = item & 15, b = (hi >> 2) & 7, h = hi & 3;
    const int lane = tid & 63, wv = __builtin_amdgcn_readfirstlane(tid >> 6), r = lane & 31, hh = lane >> 5;
    LAS unsigned char* sc = lds + EV_SC; LAS unsigned char* scp = sc;
    constexpr int NRAW = RET ? 4 : 7; constexpr int COL_K = RET ? 2560 : 512, COL_Q = RET ? 2048 : 0, COL_V = RET ? 3072 : 1024, COL_G = RET ? 3584 : 1536;
    const size_t rowbase = (size_t)b * SEQ + (size_t)c * CHUNK; const bf16* zc = Z + rowbase * EV_N;
    const int jg = tid >> 4, dc = tid & 15, j0 = 4 * jg; const unsigned voff = (unsigned)(j0 * EV_N + 8 * dc) * 2u;
    const bf16* zu = zc + h * 128;
#define EV_LD(ub, vo) (*(const GAS v4u*)((const GAS char*)(ub) + (size_t)(unsigned)(vo)))
    G4 gq{0.f, 0.f, 0.f, 0.f, h}; float mp = 0.f, npv = 0.f;
    if constexpr (!RET) {
        if (wv == 0) { const float* gp = (const float*)(P.ws() + WS_GATES) + (rowbase + 2 * lane) * 8; gq.a = gp[h]; gq.b = gp[4 + h]; gq.c = gp[8 + h]; gq.d = gp[12 + h]; mp = ((const float*)(P.ws() + WS_MPREV))[item]; }
        if (wv >= 2 && wv < 4) npv = ((const float*)(P.ws() + WS_NC))[(size_t)item * 128 + (tid - 128)];
    }
    v4u pk[NRAW], pq[NRAW], pv[4], cti[4];
    if constexpr (!RET) {
#pragma unroll
        for (int rr = 0; rr < 7; ++rr) { if (c == 0 && j0 - 3 + rr < 0) { pk[rr] = (v4u){0u, 0u, 0u, 0u}; pq[rr] = (v4u){0u, 0u, 0u, 0u}; } else { pk[rr] = EV_LD(zu + (long)(rr - 3) * EV_N + COL_K, voff); pq[rr] = EV_LD(zu + (long)(rr - 3) * EV_N + COL_Q, voff); } }
    } else {
#pragma unroll
        for (int jj = 0; jj < 4; ++jj) { pk[jj] = EV_LD(zu + (long)jj * EV_N + COL_K, voff); pq[jj] = EV_LD(zu + (long)jj * EV_N + COL_Q, voff); }
    }
#pragma unroll
    for (int jj = 0; jj < 4; ++jj) pv[jj] = EV_LD(zu + (long)jj * EV_N + COL_V, voff);
    { const unsigned char* src = (unsigned char*)P.out() + (size_t)item * 32768 + 16 * tid;
#pragma unroll
      for (int k = 0; k < 4; ++k) cti[k] = *(const GAS v4u*)(src + k * 8192); }
    if (tid < 128) *(LAS float*)(sc + SC_NG + 4 * tid) = (RET ? P.ev_ngr() : P.ev_ngm())[jl * 512 + h * 128 + tid];
    if constexpr (!RET) {
        if (wv == 0) { float mloc, tot; EV_SCALARS(true, gq, mp, lane, sc, mloc, tot); (void)mloc; (void)tot; }
        if (wv >= 2 && wv < 4) *(LAS float*)(sc + SC_N + 4 * (tid - 128)) = npv;
        if (tid >= 256) { const int isq = (tid - 256) >> 7, d = tid & 127, ch = (isq ? 512 : 0) + h * 128 + d; const float* cw = P.ev_cw() + (size_t)jl * 4096;
#pragma unroll
            for (int tap = 0; tap < 4; ++tap) *(LAS float*)(sc + SC_WL + ((isq * 5 + tap) * 128 + d) * 4) = cw[tap * 1024 + ch];
            *(LAS float*)(sc + SC_WL + ((isq * 5 + 4) * 128 + d) * 4) = P.ev_cb()[jl * 1024 + ch]; }
    } else if (tid < 128) { const float lg = __logf(1.0f - exp2f(-5.0f - (float)h));
        *(LAS float*)(sc + SC_G + 4 * tid) = __expf(lg * (float)(127 - tid)); *(LAS float*)(sc + SC_RF + 4 * tid) = __expf(lg * (float)(tid - 127)); *(LAS float*)(sc + SC_INT + 4 * tid) = __expf(lg * (float)(tid + 1)); }
    __syncthreads();
    {
        float o4[4][8]; const f32x4 gj = *(const LAS f32x4*)(scp + SC_G + 16 * jg);
        f32x4 prot[RET ? 16 : 1];
        if constexpr (RET) { const float* rp = (const float*)(P.ws() + WS_ROT) + ((size_t)(c * CHUNK + j0) * 64 + 8 * (dc & 7)) * 2;
#pragma unroll
            for (int jj = 0; jj < 4; ++jj)
#pragma unroll
                for (int e2 = 0; e2 < 4; ++e2) prot[4 * jj + e2] = *(const GAS f32x4*)(rp + jj * 128 + 4 * e2); }
        if constexpr (!RET) conv4_silu_pre(pk, sc + SC_WL + 5 * 128 * 4, dc, o4); else rot4_pre(pk, prot, dc, lane, o4);
#pragma unroll
        for (int jj = 0; jj < 4; ++jj) { const float gs = KSCALE * gj[jj];
#pragma unroll
            for (int e = 0; e < 8; ++e) o4[jj][e] *= gs;
            *(LAS v4u*)(lds + EV_K + offb(j0 + jj, dc)) = pk8(o4[jj]); }
        if constexpr (!RET) conv4_silu_pre(pq, sc + SC_WL, dc, o4); else rot4_pre(pq, prot, dc, lane, o4);
#pragma unroll
        for (int jj = 0; jj < 4; ++jj) *(LAS v4u*)(lds + EV_Q + offb(j0 + jj, dc)) = pk8(o4[jj]);
#pragma unroll
        for (int jj = 0; jj < 4; ++jj) *(LAS v4u*)(lds + EV_VT + offb(j0 + jj, dc)) = pv[jj];
#pragma unroll
        for (int k = 0; k < 4; ++k) *(LAS v4u*)(lds + EV_CT + 16 * tid + k * 8192) = cti[k];
    }
    __syncthreads();
    const int it = wv >> 1, sub = (wv & 1) * 2;
    f32x16 Pt[2], Ot[2];
    {
        const float rfi = *(const LAS float*)(scp + SC_RF + 4 * (32 * it + r));
#pragma unroll
        for (int t = 0; t < 2; ++t) { const int jt = sub + t;
#pragma unroll
            for (int i = 0; i < 16; ++i) Pt[t][i] = 0.f;
            if (jt <= it) {
#pragma unroll
                for (int s = 0; s < 8; ++s) { const bf16x8 a = *(const LAS bf16x8*)(lds + EV_K + offb(32 * jt + r, 2 * s + hh)), bq = *(const LAS bf16x8*)(lds + EV_Q + offb(32 * it + r, 2 * s + hh));
                    Pt[t] = __builtin_amdgcn_mfma_f32_32x32x16_bf16(a, bq, Pt[t], 0, 0, 0); }
#pragma unroll
                for (int i = 0; i < 16; ++i) { float v = Pt[t][i] * rfi; if (jt == it && crow(i, hh) > r) v = 0.f; Pt[t][i] = v; }
            } }
    }
    if constexpr (!RET) {
        const int i = tid >> 2, part = tid & 3; float a = 0.f;
#pragma unroll
        for (int cc = 0; cc < 4; ++cc) { float q8[8]; unpk8(*(const LAS v4u*)(lds + EV_Q + offb(i, 4 * part + cc)), q8);
            const f32x4 n0 = *(const LAS f32x4*)(sc + SC_N + 4 * (32 * part + 8 * cc)), n1 = *(const LAS f32x4*)(sc + SC_N + 4 * (32 * part + 8 * cc + 4));
            a += q8[0] * n0.x + q8[1] * n0.y + q8[2] * n0.z + q8[3] * n0.w + q8[4] * n1.x + q8[5] * n1.y + q8[6] * n1.z + q8[7] * n1.w; }
        a += sx<1>(a, lane); a += sx<2>(a, lane);
        if (part == 0) *(LAS float*)(sc + SC_QN + 4 * i) = a;
    }
    {
        const float inter = *(const LAS float*)(scp + SC_INT + 4 * (32 * it + r));
#pragma unroll
        for (int t = 0; t < 2; ++t) { const int vt2 = sub + t; f32x16 o;
#pragma unroll
            for (int i = 0; i < 16; ++i) o[i] = 0.f;
#pragma unroll
            for (int s = 0; s < 8; ++s) { const bf16x8 a = *(const LAS bf16x8*)(lds + EV_CT + offb(32 * vt2 + r, 2 * s + hh)), bq = *(const LAS bf16x8*)(lds + EV_Q + offb(32 * it + r, 2 * s + hh));
                o = __builtin_amdgcn_mfma_f32_32x32x16_bf16(a, bq, o, 0, 0, 0); }
#pragma unroll
            for (int i = 0; i < 16; ++i) Ot[t][i] = o[i] * inter; }
    }
    __syncthreads();
#pragma unroll
    for (int t = 0; t < 2; ++t) { const int jt = sub + t;
        if (jt <= it) {
#pragma unroll
            for (int q = 0; q < 4; ++q) { u32x2 w2; w2.x = pk2(Pt[t][4 * q], Pt[t][4 * q + 1]); w2.y = pk2(Pt[t][4 * q + 2], Pt[t][4 * q + 3]);
                *(LAS u32x2*)(lds + EV_K + offb(32 * it + r, 4 * jt + q) + 8 * hh) = w2; } } }
    __syncthreads();
    const int ei = tid >> 2, epart = tid & 3;
    const bf16* zrow = zc + (size_t)ei * EV_N + COL_G + h * 128 + 32 * epart;
    v4u og[4];
#pragma unroll
    for (int cc = 0; cc < 4; ++cc) og[cc] = *(const GAS v4u*)(zrow + 8 * cc);
#pragma unroll
    for (int t = 0; t < 2; ++t) { const int vt2 = sub + t;
        for (int s = 0; s < 2 * (it + 1); ++s) { const bf16x8 a = tr_frag(lds + EV_VT, lane, vt2, s), bp = *(const LAS bf16x8*)(lds + EV_K + offb(32 * it + r, 2 * s + hh));
            Ot[t] = __builtin_amdgcn_mfma_f32_32x32x16_bf16(a, bp, Ot[t], 0, 0, 0); }
#pragma unroll
        for (int q = 0; q < 4; ++q) { u32x2 w2; w2.x = pk2(Ot[t][4 * q], Ot[t][4 * q + 1]); w2.y = pk2(Ot[t][4 * q + 2], Ot[t][4 * q + 3]);
            *(LAS u32x2*)(lds + EV_Q + offb(32 * it + r, 4 * vt2 + q) + 8 * hh) = w2; } }
    __syncthreads();
    {
        float gate[32];
#pragma unroll
        for (int cc = 0; cc < 4; ++cc) { float o8[8]; unpk8(og[cc], o8);
#pragma unroll
            for (int e = 0; e < 8; ++e) gate[8 * cc + e] = RET ? siluf_(o8[e]) : sigmoidf_(o8[e]); }
        const int i = ei, part = epart; float x[32];
#pragma unroll
        for (int cc = 0; cc < 4; ++cc) { float t8[8]; unpk8(*(const LAS v4u*)(lds + EV_Q + offb(i, 4 * part + cc)), t8);
#pragma unroll
            for (int e = 0; e < 8; ++e) x[8 * cc + e] = t8[e]; }
        if constexpr (!RET) {
            float ps = 0.f;
#pragma unroll
            for (int cc = 0; cc < 4; ++cc) { float t8[8]; unpk8(*(const LAS v4u*)(lds + EV_K + offb(i, 4 * part + cc)), t8);
                ps += ((t8[0] + t8[1]) + (t8[2] + t8[3])) + ((t8[4] + t8[5]) + (t8[6] + t8[7])); }
            ps = part <= (i >> 5) ? ps : 0.f;
            ps += sx<1>(ps, lane); ps += sx<2>(ps, lane);
            const float den = ps + *(const LAS float*)(scp + SC_INT + 4 * i) * *(const LAS float*)(sc + SC_QN + 4 * i);
            const float inv = __builtin_amdgcn_rcpf(fmaxf(fabsf(den), *(const LAS float*)(scp + SC_EMM + 4 * i)));
#pragma unroll
            for (int k = 0; k < 32; ++k) x[k] *= inv * gate[k];
        }
        float s = 0.f;
#pragma unroll
        for (int k = 0; k < 32; ++k) s += x[k];
        s += sx<1>(s, lane); s += sx<2>(s, lane);
        const float mean = s * (1.0f / 128.0f); float q = 0.f;
#pragma unroll
        for (int k = 0; k < 32; ++k) { x[k] -= mean; q += x[k] * x[k]; }
        q += sx<1>(q, lane); q += sx<2>(q, lane);
        const float rstd = __builtin_amdgcn_rsqf(q * (1.0f / 128.0f) + EPS);
        bf16* mo = (bf16*)(P.ws() + WS_MIXED) + (rowbase + i) * D + (RET ? 512 : 0) + h * 128 + 32 * part;
#pragma unroll
        for (int cc = 0; cc < 4; ++cc) { const f32x4 g0 = *(const LAS f32x4*)(sc + SC_NG + 4 * (32 * part + 8 * cc)), g1 = *(const LAS f32x4*)(sc + SC_NG + 4 * (32 * part + 8 * cc + 4)); float y[8];
            y[0] = x[8 * cc] * rstd * g0.x; y[1] = x[8 * cc + 1] * rstd * g0.y; y[2] = x[8 * cc + 2] * rstd * g0.z; y[3] = x[8 * cc + 3] * rstd * g0.w;
            y[4] = x[8 * cc + 4] * rstd * g1.x; y[5] = x[8 * cc + 5] * rstd * g1.y; y[6] = x[8 * cc + 6] * rstd * g1.z; y[7] = x[8 * cc + 7] * rstd * g1.w;
            if constexpr (RET) {
#pragma unroll
                for (int e = 0; e < 8; ++e) y[e] *= gate[8 * cc + e]; }
            *(GAS v4u*)(mo + 8 * cc) = pk8(y); }
    }
    __syncthreads();
#undef EV_LD
}

struct Args { const float* in[23]; float* out; unsigned char* ws; int ph_lo, ph_hi; };
constexpr int N_PHASES = 2 + 7 * ((DEPTH + 1) / 2) + 5 * (DEPTH / 2);
#ifndef RPT_P1
#define RPT_P1 1
#endif
#ifndef RPT_P3
#define RPT_P3 1
#endif
#ifndef RPT_M
#define RPT_M 1
#endif
#ifndef RPT_R
#define RPT_R 1
#endif
#ifndef RPT_CV
#define RPT_CV 1
#endif
#ifndef RPT_WIN
#define RPT_WIN 1
#endif
#ifndef RPT_MIX
#define RPT_MIX 1
#endif
#ifndef RPT_GU
#define RPT_GU 1
#endif
#ifndef MK_ONE_LAUNCH
#define MK_ONE_LAUNCH 1
#endif
__global__ void __launch_bounds__(NWAVES * 64, 2) mk_fwd(Args args) {
    extern __shared__ __attribute__((aligned(16))) unsigned char lds_raw[];
    LAS unsigned char* lds = (LAS unsigned char*)lds_raw;
    volatile LAS unsigned* MISC = (volatile LAS unsigned*)(lds + MISC_OFF);
    const int wave_s = __builtin_amdgcn_readfirstlane((int)threadIdx.x >> 6);
#define HWTID() (wave_s * 64 + hw_lane())
    const int G = gridDim.x, bx = blockIdx.x;
    const int vcu = (G % 8 == 0) ? (bx % 8) * (G / 8) + bx / 8 : bx;
    const int NGW = G * NWAVES;
#define GW (vcu * NWAVES + wave)
    const Ptrs P;
    gu32* ctl = (gu32*)(P.ws() + WS_CTL);
    for (int u = HWTID(); u < (LDS_BYTES - LDSCTL_OFF) / 4; u += NWAVES * 64) ((LAS unsigned*)(lds + LDSCTL_OFF))[u] = 0u;
    __syncthreads();
    const int lo = P.ph_lo(), hi = P.ph_hi();
    const bool use_bar = (hi - lo) > 1;
    XcdBarrier bar; bar.bar = (unsigned*)(ctl + CW_BAR); bar.x = 0; bar.st = nullptr;
    if (use_bar) bar = xcd_barrier_post((unsigned*)(ctl + CW_BAR), MISC + 8, HWTID());
#define IN(k) (lo <= (k) && (k) < hi)
#define FRESH() int tid = HWTID(); asm volatile("" : "+v"(tid)); const int lane = tid & 63, wave = __builtin_amdgcn_readfirstlane(tid >> 6); (void)lane; (void)wave
#define TAIL_CV(nwg_, body_) do { const int rem_ = (nwg_) % G; if (rem_ == 0 || bx >= rem_) { FRESH(); const int wk = (rem_ ? bx - rem_ : bx) * NWAVES + wave, NWK = (rem_ ? G - rem_ : G) * NWAVES; \
        LAS float* scr = (LAS float*)(lds + RING_OFF + wave * 16384); (void)lane; body_; } } while (0)
#define SEAM(k) do { if (IN(k) && IN((k) + 1)) xcd_barrier(bar, HWTID()); } while (0)

#define XB ((bf16*)(P.ws() + WS_XB))
#define MIXED ((bf16*)(P.ws() + WS_MIXED))
#define ZB ((bf16*)(P.ws() + WS_Z))
#define ACT ((bf16*)(P.ws() + WS_Z))
#define SSQ ((float*)(P.ws() + WS_SSQ))
    if (IN(0)) { FRESH(); LAS float* scr = (LAS float*)(lds + RING_OFF + wave * 16384); prologue_rows(P, GW, NGW, lane); cv_in(P, 0, scr, GW, NGW, lane); cv_out(P, 0, scr, GW, NGW, lane); }
    SEAM(0);
    int pbase = 0;
    for (int L = 0; L < DEPTH; ++L) {
        const int j = L >> 1; const bool even = (L & 1) == 0;
        const int p_in = pbase + 1, p_mix = pbase + 2, p_out = pbase + (even ? 5 : 3), p_gu = p_out + 1, p_dn = p_out + 2; pbase = p_dn;
        if (IN(p_in)) for (int rp = 0; rp < RPT_WIN; ++rp) {
            if (rp) xcd_barrier(bar, HWTID());
            const int N = even ? EV_N : OD_N;
            pg8::Gemm g{XB, (const bf16*)(P.ws() + (even ? WS_WIN_A : WS_WIN_B)), M, N, D}; pg8::StaticOrder S; S.init(M, N, G, bx);
            pg8::EpiZ E{ZB, N, SSQ};
            pg8::gemm_phase<pg8::EpiZ, pg8::StaticOrder, true, true>(lds + RING_OFF, g, S, E, HWTID());
            if (even) { FRESH(); gates_rows(P, j, GW, NGW, lane); }
            else if (L == 1) { TAIL_CV((M / 256) * (OD_N / 256), cv_ffn(P, 2, scr, wk, NWK, lane)); }
        }
        SEAM(p_in);
        if (even) {
            if (IN(p_mix)) for (int rp = 0; rp < RPT_P1; ++rp) { if (rp) xcd_barrier(bar, HWTID()); FRESH();
                for (int it = bx; it < 1024; it += G) { if ((it >> 4) >= 32) ev_p1_item<true>(P, j, lds, it, tid); else ev_p1_item<false>(P, j, lds, it, tid); }
                LAS float* scr = (LAS float*)(lds + RING_OFF + wave * 16384);
                if (L == 0) cv_ffn(P, 0, scr, GW, NGW, lane); }
            SEAM(p_mix);
            if (IN(p_mix + 1)) { FRESH(); ev_p2_scan(P, (bx * NWAVES + wave) * 64 + lane, G * NWAVES * 64); }
            SEAM(p_mix + 1);
            if (IN(p_mix + 2)) for (int rp = 0; rp < RPT_P3; ++rp) { if (rp) xcd_barrier(bar, HWTID()); FRESH();
                for (int it = bx; it < 1024; it += G) { if ((it >> 4) >= 32) ev_p3_item<true>(P, j, lds, it, tid); else ev_p3_item<false>(P, j, lds, it, tid); } }
            SEAM(p_mix + 2);
        } else {
            if (IN(p_mix)) { FRESH(); for (int it = bx; it < M / 64; it += G) od_fast_item(P, j, lds, it, tid); }
            SEAM(p_mix);
        }
        if (IN(p_out)) {
            pg8::Gemm g{MIXED, (const bf16*)(P.ws() + WS_WOUT) + (size_t)L * D * D, M, D, D}; pg8::StaticOrder S; S.init(M, D, G, bx);
            pg8::EpiRes E{XB, SSQ, D};
            pg8::gemm_phase<pg8::EpiRes, pg8::StaticOrder, true, true>(lds + RING_OFF, g, S, E, HWTID());
        }
        SEAM(p_out);
        if (IN(p_gu)) for (int rp = 0; rp < RPT_GU; ++rp) {
            if (rp) xcd_barrier(bar, HWTID());
            pg8::Gemm g{XB, (const bf16*)(P.ws() + (even ? WS_WGU_A : WS_WGU_B)), M, NGU, D}; pg8::StaticOrder S; S.init(M, NGU, G, bx);
            pg8::EpiSwiGLU E{ACT, DFF, SSQ};
            pg8::gemm_phase<pg8::EpiSwiGLU, pg8::StaticOrder, true, true>(lds + RING_OFF, g, S, E, HWTID());
            if (L == 0) { TAIL_CV((M / 256) * (NGU / 256), (cv_in(P, 1, scr, wk, NWK, lane), cv_out(P, 1, scr, wk, NWK, lane), cv_ffn(P, 1, scr, wk, NWK, lane))); }
            else if (L == 1) { TAIL_CV((M / 256) * (NGU / 256), (cv_in(P, 2, scr, wk, NWK, lane), cv_out(P, 2, scr, wk, NWK, lane), cv_in(P, 3, scr, wk, NWK, lane), cv_out(P, 3, scr, wk, NWK, lane))); }
            else if (L == 2) { TAIL_CV((M / 256) * (NGU / 256), cv_ffn(P, 3, scr, wk, NWK, lane)); }
        }
        SEAM(p_gu);
        if (IN(p_dn)) {
            pg8::Gemm g{ACT, (const bf16*)(P.ws() + (even ? WS_WD_A : WS_WD_B)), M, D, DFF}; pg8::StaticOrder S; S.init(M, D, G, bx);
            pg8::EpiRes E{XB, SSQ, D};
            pg8::gemm_phase<pg8::EpiRes, pg8::StaticOrder, true, true>(lds + RING_OFF, g, S, E, HWTID());
        }
        SEAM(p_dn);
    }
    if (IN(N_PHASES - 1)) { FRESH(); final_norm(P, GW, NGW, lane); }
#undef IN
#undef SEAM
#undef TAIL_CV
#undef FRESH
#undef HWTID
#undef GW
#undef XB
#undef MIXED
#undef ZB
#undef ACT
#undef SSQ
}

extern "C" void kernel_launch(void* const* d_in, const int* in_sizes, int n_in, void* d_out, int out_size, void* d_ws, size_t ws_size, hipStream_t stream) {
    static int grid = 0;
    if (grid == 0) {
        if (n_in != 23 || in_sizes[0] != M * D || out_size != M * D || ws_size < WS_END) { fprintf(stderr, "kernel_launch: unexpected shapes (n_in %d, in0 %d, out %d, ws %zu)\n", n_in, n_in > 0 ? in_sizes[0] : -1, out_size, ws_size); grid = -1; return; }
        int dev = 0, cus = 0, per_cu = 0;
        if (hipGetDevice(&dev) != hipSuccess || hipDeviceGetAttribute(&cus, hipDeviceAttributeMultiprocessorCount, dev) != hipSuccess) { grid = -1; return; }
        if (hipFuncSetAttribute((const void*)mk_fwd, hipFuncAttributeMaxDynamicSharedMemorySize, LDS_BYTES) != hipSuccess) { fprintf(stderr, "kernel_launch: hipFuncSetAttribute failed\n"); grid = -1; return; }
        if (hipOccupancyMaxActiveBlocksPerMultiprocessor(&per_cu, (const void*)mk_fwd, NWAVES * 64, LDS_BYTES) != hipSuccess || per_cu < 1) { fprintf(stderr, "kernel_launch: occupancy query reports %d blocks per CU\n", per_cu); per_cu = 1; }
        (void)hipGetLastError();
        grid = cus;
        if (grid > 256) grid = 256;
    }
    if (grid < 0) return;
    (void)hipMemsetAsync((char*)d_ws + WS_CTL, 0, CTL_ZERO_BYTES, stream);
    Args a{};
    for (int i = 0; i < 23; ++i) a.in[i] = (const float*)d_in[i];
    a.out = (float*)d_out; a.ws = (unsigned char*)d_ws;
#if MK_ONE_LAUNCH
    a.ph_lo = 0; a.ph_hi = N_PHASES;
    hipLaunchKernelGGL(mk_fwd, dim3(grid), dim3(NWAVES * 64), LDS_BYTES, stream, a);
#else
    for (int ph = 0; ph < N_PHASES; ++ph) { a.ph_lo = ph; a.ph_hi = ph + 1; hipLaunchKernelGGL(mk_fwd, dim3(grid), dim3(NWAVES * 64), LDS_BYTES, stream, a); }
#endif
}
```

```cpp
#include <hip/hip_runtime.h>
#include <cstdio>
#include <cstdint>
#include <cmath>

template <int MASK> __device__ __forceinline__ float sx(float v, int lane) {
    if constexpr (MASK < 32) return __builtin_bit_cast(float, __builtin_amdgcn_ds_swizzle(__builtin_bit_cast(int, v), (MASK << 10) | 0x1f));
    else return __builtin_bit_cast(float, __builtin_amdgcn_ds_bpermute((lane ^ 32) << 2, __builtin_bit_cast(int, v)));
}
template <int MASK> __device__ __forceinline__ unsigned sxu(unsigned v, int lane) {
    if constexpr (MASK < 32) return (unsigned)__builtin_amdgcn_ds_swizzle((int)v, (MASK << 10) | 0x1f);
    else return (unsigned)__builtin_amdgcn_ds_bpermute((lane ^ 32) << 2, (int)v);
}
__device__ __forceinline__ float shup(float v, int o, int lane) { return __builtin_bit_cast(float, __builtin_amdgcn_ds_bpermute((lane - o) << 2, __builtin_bit_cast(int, v))); }
namespace pg8 {
#define PG8_LAS __attribute__((address_space(3)))
typedef unsigned short bf16_t;
typedef short bf16x8 __attribute__((ext_vector_type(8)));
typedef float f32x4 __attribute__((ext_vector_type(4)));
typedef unsigned u32x4 __attribute__((ext_vector_type(4)));
constexpr int BM = 256, BK = 64, HALF = 128, HTB = HALF * BK * 2  , STAGE_BYTES = 8 * HTB, NXCD = 8, WGM = 8;

__host__ __device__ __forceinline__ int lds_byte(int r, int c) { const int st = (r >> 4) * 2 + (c >> 5), rr = r & 15, cc = c & 31, ob = rr * 64 + cc * 2; return st * 1024 + (ob ^ (((ob >> 9) & 1) << 5)); }
__host__ __device__ __forceinline__ void stage_rc(int b, int& R, int& C) { const int st = b / 1024, sb = b % 1024, swz = sb ^ (((sb >> 9) & 1) << 5); R = (st >> 1) * 16 + swz / 64; C = (st & 1) * 32 + (swz % 64) / 2; }
__host__ __device__ __forceinline__ int perm32(int rho) { const int n = rho >> 4, i = rho & 15; return 8 * (i >> 2) + 4 * n + (i & 3); }

struct Unit { int pm, pn; };
struct Gemm { const bf16_t* A; const bf16_t* Bt; int M, N, K; };

struct StaticOrder {
    int nM, nN, nwg, G, c;
    __host__ __device__ void init(int M, int N, int G_, int c_) { nM = M / BM; nN = N / BM; nwg = nM * nN; G = G_; c = c_; }
    __host__ __device__ bool next(int i, Unit& u) const {
        const long L = (long)i * G + c; if (L >= nwg) return false;
        int wgid = (int)L; { const int q = nwg / NXCD, r = nwg % NXCD, xcd = wgid % NXCD, off = wgid / NXCD; wgid = (xcd < r ? xcd * (q + 1) : r * (q + 1) + (xcd - r) * q) + off; }
        const int nig = WGM * nN, gid = wgid / nig, fm = gid * WGM, gsz = (nM - fm) < WGM ? (nM - fm) : WGM;
        u.pm = fm + ((wgid % nig) % gsz); u.pn = (wgid % nig) / gsz; return true;
    }
    __device__ __forceinline__ void a_ready(const Unit&) const {}
    __device__ __forceinline__ void done(const Unit&) const {}
};


__device__ __forceinline__ unsigned cvt_pk_bf16(float lo, float hi) { unsigned r; asm volatile("v_cvt_pk_bf16_f32 %0, %1, %2" : "=v"(r) : "v"(lo), "v"(hi)); return r; }
typedef float f32x2 __attribute__((ext_vector_type(2)));

typedef float f32x2 __attribute__((ext_vector_type(2)));
typedef unsigned u32x2 __attribute__((ext_vector_type(2)));
constexpr float RMS_EPS = 1e-6f;
__device__ __forceinline__ float row_rstd(const float* ssq, int row, int fq, int lane) {
    const f32x4 p = *(const f32x4*)(ssq + (size_t)row * 16 + 4 * fq);
    float s = (p[0] + p[1]) + (p[2] + p[3]);
    s += sx<16>(s, lane); s += sx<32>(s, lane);
    return __builtin_amdgcn_rsqf(s * (1.0f / 1024.0f) + RMS_EPS);
}
__device__ __forceinline__ void row_rstd8(const float* ssq, int row0, int fq, int lane, float (&rs)[2][4]) {
    f32x4 p[2][4];
#pragma unroll
    for (int ai = 0; ai < 2; ++ai)
#pragma unroll
        for (int m = 0; m < 4; ++m) p[ai][m] = *(const f32x4*)(ssq + (size_t)(row0 + ai * HALF + m * 16) * 16 + 4 * fq);
    asm volatile("" : "+v"(p[0][0]), "+v"(p[0][1]), "+v"(p[0][2]), "+v"(p[0][3]), "+v"(p[1][0]), "+v"(p[1][1]), "+v"(p[1][2]), "+v"(p[1][3]));
#pragma unroll
    for (int ai = 0; ai < 2; ++ai)
#pragma unroll
        for (int m = 0; m < 4; ++m) { float s = (p[ai][m][0] + p[ai][m][1]) + (p[ai][m][2] + p[ai][m][3]); s += sx<16>(s, lane); s += sx<32>(s, lane); rs[ai][m] = __builtin_amdgcn_rsqf(s * (1.0f / 1024.0f) + RMS_EPS); }
}
struct EpiZ {
    static constexpr bool PERM = true, AFTER_DRAIN = false;
    bf16_t* O; int ldc; const float* ssq;
    __device__ __forceinline__ void operator()(const f32x4 (&acc)[2][2][4][2], const Unit& u, int wr, int wc, int fr, int fq) const {
        const int row0 = u.pm * BM + wr * 64 + fr, col0 = u.pn * BM + wc * 32 + 8 * fq;
        float rsv[2][4]; row_rstd8(ssq, row0, fq, fq * 16 + fr, rsv);
#pragma unroll
        for (int ai = 0; ai < 2; ++ai)
#pragma unroll
            for (int m = 0; m < 4; ++m) { const int row = row0 + ai * HALF + m * 16; const float rs = rsv[ai][m];
                bf16_t* rowp = O + (size_t)row * ldc + col0;
#pragma unroll
                for (int bj = 0; bj < 2; ++bj) { const f32x4 v0 = acc[ai][bj][m][0] * rs, v1 = acc[ai][bj][m][1] * rs;
                    u32x4 w; w.x = cvt_pk_bf16(v0[0], v0[1]); w.y = cvt_pk_bf16(v0[2], v0[3]); w.z = cvt_pk_bf16(v1[0], v1[1]); w.w = cvt_pk_bf16(v1[2], v1[3]);
                    *(u32x4*)(rowp + bj * HALF) = w; } }
    }
};
struct EpiSwiGLU {
    static constexpr bool PERM = true, AFTER_DRAIN = false;
    bf16_t* O; int ldc; const float* ssq;
    __device__ __forceinline__ void operator()(const f32x4 (&acc)[2][2][4][2], const Unit& u, int wr, int wc, int fr, int fq) const {
        const int row0 = u.pm * BM + wr * 64 + fr, col0 = u.pn * HALF + wc * 32 + 8 * fq;
        float rsv[2][4]; row_rstd8(ssq, row0, fq, fq * 16 + fr, rsv);
#pragma unroll
        for (int ai = 0; ai < 2; ++ai)
#pragma unroll
            for (int m = 0; m < 4; ++m) { const int row = row0 + ai * HALF + m * 16; const float rs = rsv[ai][m];
                float o[8];
#pragma unroll
                for (int n = 0; n < 2; ++n)
#pragma unroll
                    for (int e = 0; e < 4; ++e) { const float g = acc[ai][0][m][n][e] * rs, up = acc[ai][1][m][n][e] * rs;
                        const float sg = g * __builtin_amdgcn_rcpf(1.0f + __builtin_amdgcn_exp2f(-1.4426950408889634f * g)); o[4 * n + e] = sg * up; }
                u32x4 w; w.x = cvt_pk_bf16(o[0], o[1]); w.y = cvt_pk_bf16(o[2], o[3]); w.z = cvt_pk_bf16(o[4], o[5]); w.w = cvt_pk_bf16(o[6], o[7]);
                *(u32x4*)(O + (size_t)row * ldc + col0) = w; }
    }
};
struct EpiRes {
    static constexpr bool PERM = false, AFTER_DRAIN = false;
    bf16_t* xb; float* ssq; int ldc;
    __device__ __forceinline__ void operator()(const f32x4 (&acc)[2][2][4][2], const Unit& u, int wr, int wc, int fr, int fq) const {
        const int row0 = u.pm * BM + wr * 64 + fr, col0 = u.pn * BM + wc * 32 + 4 * fq;
#pragma unroll
        for (int ai = 0; ai < 2; ++ai)
#pragma unroll
            for (int m = 0; m < 4; ++m) { const int row = row0 + ai * HALF + m * 16; const size_t off = (size_t)row * ldc + col0; float q = 0.f;
#pragma unroll
                for (int bj = 0; bj < 2; ++bj)
#pragma unroll
                    for (int n = 0; n < 2; ++n) { const size_t o2 = off + bj * HALF + n * 16; const u32x2 xo = *(const u32x2*)(xb + o2);
                        f32x4 xn; xn[0] = __builtin_bit_cast(float, xo.x << 16); xn[1] = __builtin_bit_cast(float, xo.x & 0xffff0000u); xn[2] = __builtin_bit_cast(float, xo.y << 16); xn[3] = __builtin_bit_cast(float, xo.y & 0xffff0000u);
                        xn += acc[ai][bj][m][n];
                        u32x2 w; w.x = cvt_pk_bf16(xn[0], xn[1]); w.y = cvt_pk_bf16(xn[2], xn[3]); *(u32x2*)(xb + o2) = w;
                        q += (xn[0] * xn[0] + xn[1] * xn[1]) + (xn[2] * xn[2] + xn[3] * xn[3]); }
                q += sx<16>(q, fq * 16 + fr); q += sx<32>(q, fq * 16 + fr);
                if (fq == 0) ssq[(size_t)row * 16 + u.pn * 4 + wc] = q;
                asm volatile("" ::: "memory"); }
    }
};


template <class Epi, class Sched, bool ALIGN_EPI = false, bool SP2 = false>
__device__ __forceinline__ void gemm_phase(PG8_LAS unsigned char* lds, const Gemm g, const Sched& S, const Epi& E, int tid_in) {
    int tid_ = tid_in; asm volatile("" : "+v"(tid_));
    const int tid = tid_, wid = __builtin_amdgcn_readfirstlane(tid >> 6), lane = tid & 63, wr = wid >> 2, wc = wid & 3, fr = lane & 15, fq = lane >> 4;
    const int K = g.K, nt = K / BK;
    unsigned voffA[2], voffB[2];
#pragma unroll
    for (int i = 0; i < 2; ++i) { int R, C; stage_rc(tid * 16 + i * 8192, R, C); const int Rb = Epi::PERM ? ((R & ~31) + perm32(R & 31)) : R;
        voffA[i] = (unsigned)(R * K + C) * 2u; voffB[i] = (unsigned)(Rb * K + C) * 2u; }
    const size_t kstep = (size_t)(BK * 2);
    const size_t hstep = (size_t)HALF * K * 2;
    const size_t tstep = 2 * hstep;
    const unsigned ldsw = (unsigned)wid * 1024u;
    const int aoff = lds_byte(wr * 64 + fr, fq * 8), boff = lds_byte(wc * 32 + fr, fq * 8);
#define PG8_SA(b, h) (((b) * 2 + (h)) * HTB)
#define PG8_SB(b, h) ((4 + (b) * 2 + (h)) * HTB)
#define PG8_STAGE(bufoff, gbase, voff) do { _Pragma("unroll") for (int _i = 0; _i < 2; ++_i) \
        __builtin_amdgcn_global_load_lds((const unsigned*)((const char*)(gbase) + (voff)[_i]), (PG8_LAS unsigned*)(lds + (bufoff) + ldsw + _i * 8192), 16, 0, 0); } while (0)
#define PG8_LDA(dst, b, h) do { _Pragma("unroll") for (int m = 0; m < 4; ++m) _Pragma("unroll") for (int k = 0; k < 2; ++k) dst[m][k] = *(const PG8_LAS bf16x8*)(lds + PG8_SA(b, h) + aoff + m * 2048 + k * 1024); } while (0)
#define PG8_LDB(dst, b, h) do { _Pragma("unroll") for (int n = 0; n < 2; ++n) _Pragma("unroll") for (int k = 0; k < 2; ++k) dst[n][k] = *(const PG8_LAS bf16x8*)(lds + PG8_SB(b, h) + boff + n * 2048 + k * 1024); } while (0)
#define PG8_MMA(ai, bj, At, Bt) do { __builtin_amdgcn_s_setprio(1); _Pragma("unroll") for (int m = 0; m < 4; ++m) _Pragma("unroll") for (int n = 0; n < 2; ++n) _Pragma("unroll") for (int k = 0; k < 2; ++k) \
        acc[ai][bj][m][n] = __builtin_amdgcn_mfma_f32_16x16x32_bf16(Bt[n][k], At[m][k], acc[ai][bj][m][n], 0, 0, 0); __builtin_amdgcn_s_setprio(0); } while (0)
#define PG8_WAIT_V(n) asm volatile("s_waitcnt vmcnt(" #n ")" ::: "memory")
#define PG8_WAIT_L(n) asm volatile("s_waitcnt lgkmcnt(" #n ")" ::: "memory")
#define PG8_BAR __builtin_amdgcn_s_barrier()
#define PG8_SCHED __builtin_amdgcn_sched_barrier(0)
    Unit cur, nxt; int ui = 0;
    if (!S.next(0, cur)) return;
    f32x4 acc[2][2][4][2];
#pragma unroll
    for (int a = 0; a < 2; ++a)
#pragma unroll
        for (int b = 0; b < 2; ++b)
#pragma unroll
            for (int m = 0; m < 4; ++m)
#pragma unroll
                for (int n = 0; n < 2; ++n) acc[a][b][m][n] = (f32x4){0.f, 0.f, 0.f, 0.f};
    bf16x8 At[4][2], B0[2][2], B1[2][2];
    const char* cA = (const char*)g.A + (size_t)cur.pm * tstep; const char* cB = (const char*)g.Bt + (size_t)cur.pn * tstep;
    S.a_ready(cur);
    if constexpr (SP2) {
        PG8_STAGE(PG8_SB(0, 0), cB, voffB); PG8_STAGE(PG8_SB(0, 1), cB + hstep, voffB); PG8_STAGE(PG8_SA(0, 0), cA, voffA); PG8_STAGE(PG8_SA(0, 1), cA + hstep, voffA);
        if (wr == 1) PG8_BAR;
        PG8_WAIT_V(2); PG8_BAR;
        PG8_STAGE(PG8_SB(1, 0), cB + kstep, voffB); PG8_STAGE(PG8_SA(1, 0), cA + kstep, voffA); PG8_STAGE(PG8_SB(1, 1), cB + hstep + kstep, voffB);
        PG8_WAIT_V(6); PG8_BAR;
    } else {
        PG8_STAGE(PG8_SB(0, 0), cB, voffB); PG8_STAGE(PG8_SA(0, 0), cA, voffA); PG8_STAGE(PG8_SB(0, 1), cB + hstep, voffB); PG8_STAGE(PG8_SA(0, 1), cA + hstep, voffA);
        if (wr == 1) PG8_BAR;
        PG8_WAIT_V(4); PG8_BAR;
        PG8_STAGE(PG8_SB(1, 0), cB + kstep, voffB); PG8_STAGE(PG8_SA(1, 0), cA + kstep, voffA); PG8_STAGE(PG8_SB(1, 1), cB + hstep + kstep, voffB);
        PG8_WAIT_V(6); PG8_BAR;
    }
    for (;;) {
        const bool has_next = S.next(ui + 1, nxt);
        const char* nA = has_next ? (const char*)g.A + (size_t)nxt.pm * tstep : cA; const char* nB = has_next ? (const char*)g.Bt + (size_t)nxt.pn * tstep : cB;
        for (int t = 0; t < nt; t += 2) {
            const bool last = (t == nt - 2);
            const char* a1 = cA + (size_t)(t + 1) * kstep;
            const char* a2 = last ? nA : cA + (size_t)(t + 2) * kstep; const char* b2 = last ? nB : cB + (size_t)(t + 2) * kstep;
            const char* a3 = a2 + kstep; const char* b3 = b2 + kstep;
            if (last && has_next) S.a_ready(nxt);
            if constexpr (SP2) {
            PG8_LDB(B0, 0, 0); PG8_LDB(B1, 0, 1); PG8_SCHED; PG8_LDA(At, 0, 0); PG8_STAGE(PG8_SA(1, 1), a1 + hstep, voffA);
            PG8_WAIT_V(8); PG8_WAIT_L(0); PG8_BAR; PG8_MMA(0, 0, At, B0); PG8_MMA(0, 1, At, B1); PG8_BAR; PG8_SCHED;
            PG8_LDA(At, 0, 1); PG8_STAGE(PG8_SB(0, 0), b2, voffB); PG8_STAGE(PG8_SB(0, 1), b2 + hstep, voffB); PG8_STAGE(PG8_SA(0, 0), a2, voffA);
            PG8_WAIT_V(8); PG8_WAIT_L(0); PG8_BAR; PG8_MMA(1, 0, At, B0); PG8_MMA(1, 1, At, B1); PG8_BAR; PG8_SCHED;
            PG8_LDB(B0, 1, 0); PG8_LDB(B1, 1, 1); PG8_SCHED; PG8_LDA(At, 1, 0); PG8_STAGE(PG8_SA(0, 1), a2 + hstep, voffA);
            PG8_WAIT_V(8); PG8_WAIT_L(0); PG8_BAR; PG8_MMA(0, 0, At, B0); PG8_MMA(0, 1, At, B1); PG8_BAR; PG8_SCHED;
            PG8_LDA(At, 1, 1); PG8_STAGE(PG8_SB(1, 0), b3, voffB); PG8_STAGE(PG8_SB(1, 1), b3 + hstep, voffB); PG8_STAGE(PG8_SA(1, 0), a3, voffA);
            PG8_WAIT_V(8); PG8_WAIT_L(0); PG8_BAR; PG8_MMA(1, 0, At, B0); PG8_MMA(1, 1, At, B1); PG8_BAR; PG8_SCHED;
            } else {
            PG8_LDB(B0, 0, 0); PG8_SCHED; PG8_LDA(At, 0, 0); PG8_STAGE(PG8_SA(1, 1), a1 + hstep, voffA);
            PG8_WAIT_L(8); PG8_BAR; PG8_WAIT_L(0); PG8_MMA(0, 0, At, B0); PG8_BAR; PG8_SCHED;
            PG8_LDB(B1, 0, 1); PG8_STAGE(PG8_SB(0, 0), b2, voffB);
            PG8_BAR; PG8_WAIT_L(0); PG8_MMA(0, 1, At, B1); PG8_BAR;
            PG8_LDA(At, 0, 1); PG8_STAGE(PG8_SA(0, 0), a2, voffA);
            PG8_BAR; PG8_WAIT_L(0); PG8_MMA(1, 0, At, B0); PG8_BAR; PG8_SCHED;
            PG8_STAGE(PG8_SB(0, 1), b2 + hstep, voffB);
            PG8_WAIT_V(6); PG8_BAR; PG8_MMA(1, 1, At, B1); PG8_BAR;
            PG8_LDB(B0, 1, 0); PG8_SCHED; PG8_LDA(At, 1, 0); PG8_STAGE(PG8_SA(0, 1), a2 + hstep, voffA);
            PG8_WAIT_L(8); PG8_BAR; PG8_WAIT_L(0); PG8_MMA(0, 0, At, B0); PG8_BAR; PG8_SCHED;
            PG8_LDB(B1, 1, 1); PG8_STAGE(PG8_SB(1, 0), b3, voffB);
            PG8_BAR; PG8_WAIT_L(0); PG8_MMA(0, 1, At, B1); PG8_BAR;
            PG8_LDA(At, 1, 1); PG8_STAGE(PG8_SA(1, 0), a3, voffA);
            PG8_BAR; PG8_WAIT_L(0); PG8_MMA(1, 0, At, B0); PG8_BAR; PG8_SCHED;
            PG8_STAGE(PG8_SB(1, 1), b3 + hstep, voffB);
            PG8_WAIT_V(6); PG8_BAR; PG8_MMA(1, 1, At, B1); PG8_BAR;
            }
        }
        if constexpr (ALIGN_EPI) { if (wr == 0) PG8_BAR; }
        if constexpr (!Epi::AFTER_DRAIN) { E(acc, cur, wr, wc, fr, fq); S.done(cur); }
        if (!has_next) break;
#pragma unroll
        for (int a = 0; a < 2; ++a)
#pragma unroll
            for (int b = 0; b < 2; ++b)
#pragma unroll
                for (int m = 0; m < 4; ++m)
#pragma unroll
                    for (int n = 0; n < 2; ++n) acc[a][b][m][n] = (f32x4){0.f, 0.f, 0.f, 0.f};
        cur = nxt; cA = nA; cB = nB; ++ui;
        if constexpr (ALIGN_EPI) { if (wr == 1) PG8_BAR; }
    }
    PG8_WAIT_V(0);
    if constexpr (!ALIGN_EPI) { if (wr == 0) PG8_BAR; }
    PG8_BAR;
    if constexpr (Epi::AFTER_DRAIN) { E.fused(acc, cur, wr, wc, fr, fq, lds, wid, lane); S.done(cur); }
#undef PG8_SA
#undef PG8_SB
#undef PG8_STAGE
#undef PG8_LDA
#undef PG8_LDB
#undef PG8_MMA
#undef PG8_WAIT_V
#undef PG8_WAIT_L
#undef PG8_BAR
#undef PG8_SCHED
}
}


constexpr int NWAVES = 8;
constexpr int BATCH = 8, SEQ = 2048, D = 1024, M = BATCH * SEQ, DEPTH = 4, DFF = 2816, NGU = 2 * DFF;
constexpr int EV_N = 4096, EV_IN = 4104, OD_N = 1536, HD = 128, CHUNK = 128;
constexpr float EPS = 1e-6f;
constexpr float KSCALE = 0.08838834764831845f;
constexpr size_t MiB = 1u << 20;
constexpr size_t WS_CTL = 0, CTL_ZERO_BYTES = 65536;
constexpr size_t WS_ROT = 1 * MiB;
constexpr size_t WS_GATES = 2 * MiB;
constexpr size_t WS_WTG = 2 * MiB + 512 * 1024;
constexpr size_t WS_WTP = WS_WTG + 65536;
constexpr size_t WS_SSQ = 3 * MiB;
constexpr size_t WS_WIN_A = 4 * MiB;
constexpr size_t WS_WIN_B = 12 * MiB;
constexpr size_t WS_WOUT = 16 * MiB;
constexpr size_t WS_WGU_A = 24 * MiB, WS_WD_A = 35 * MiB;
constexpr size_t WS_WGU_B = 41 * MiB, WS_WD_B = 52 * MiB;
constexpr size_t WS_XB = 58 * MiB;
constexpr size_t WS_MIXED = 90 * MiB;
constexpr size_t WS_Z = 122 * MiB;
constexpr size_t WS_END = 250 * MiB;
constexpr int CW_TMO = 0, CW_CODE = 1, CW_BAR = 4096;
constexpr int RING_OFF = 0, RING_BYTES = 131072;
constexpr int LDSCTL_OFF = RING_BYTES, MISC_OFF = LDSCTL_OFF + 320;
constexpr int LDS_BYTES = 147456;


#define GAS __attribute__((address_space(1)))
#define LAS __attribute__((address_space(3)))
typedef unsigned short bf16;
typedef unsigned v4u __attribute__((ext_vector_type(4)));
typedef float f32x4 __attribute__((ext_vector_type(4)));
typedef short bf16x8 __attribute__((ext_vector_type(8)));
typedef GAS unsigned gu32;
typedef GAS unsigned long long gu64;
#define RLX_AGENT __ATOMIC_RELAXED, __HIP_MEMORY_SCOPE_AGENT
#define LDS_WAIT() asm volatile("s_waitcnt lgkmcnt(0)" ::: "memory")
#define VM_WAIT() asm volatile("s_waitcnt vmcnt(0)" ::: "memory")
__device__ __forceinline__ unsigned long long rt() { return __builtin_amdgcn_s_memrealtime(); }
__device__ __forceinline__ unsigned f2bf(float f) { unsigned u = __builtin_bit_cast(unsigned, f); return (u + 0x7fffu + ((u >> 16) & 1u)) >> 16; }
typedef float f32x2_cv __attribute__((ext_vector_type(2))); typedef __bf16 bf16x2_cv __attribute__((ext_vector_type(2)));
__device__ __forceinline__ unsigned pk2(float lo, float hi) { const f32x2_cv v = {lo, hi}; return __builtin_bit_cast(unsigned, __builtin_convertvector(v, bf16x2_cv)); }

#define XB_TMO      128
#define XB_XCNT(j)  (256  + 64 * (j))
#define XB_XSUB(j)  (1280 + 64 * (j))
#define XB_XGEN(j)  (2304 + 64 * (j))
#define XB_TOP      3328
#define XB_TOPGEN   3392
#define XCD_BAR_WORDS 3456
#define XB_SPIN_CAP (1u << 18)

__device__ __forceinline__ unsigned xb_ld(unsigned* p)              { return __hip_atomic_load(p, __ATOMIC_RELAXED, __HIP_MEMORY_SCOPE_AGENT); }
__device__ __forceinline__ unsigned xb_add(unsigned* p, unsigned v) { return __hip_atomic_fetch_add(p, v, __ATOMIC_RELAXED, __HIP_MEMORY_SCOPE_AGENT); }
__device__ __forceinline__ unsigned xb_xcc_id() { return (unsigned)__builtin_amdgcn_s_getreg((3 << 11) | 20) & 0xFu; }
#define XB_SPIN(cond, bar) do { unsigned _sp = 0; while (cond) { __builtin_amdgcn_s_sleep(0); \
    if ((++_sp & 255u) == 0u) { if (xb_ld(&(bar)[XB_TMO])) break; if (_sp > XB_SPIN_CAP) { atomicAdd(&(bar)[XB_TMO], 1u); break; } } } } while (0)

struct XcdBarrier {
    unsigned* bar; unsigned x;
    volatile LAS unsigned* st;
};

__device__ __forceinline__ XcdBarrier xcd_barrier_post(unsigned* bar, volatile LAS unsigned* st, int tid_b) {
    XcdBarrier b; b.bar = bar; b.x = xb_xcc_id(); b.st = st;
    if (tid_b == 0) (void)xb_add(&bar[XB_XCNT(b.x)], 1u);
    return b;
}
__device__ __forceinline__ void xcd_barrier_complete(unsigned* bar, unsigned x, unsigned& nloc, unsigned& nx) {
    const unsigned G = gridDim.x * gridDim.y * gridDim.z;
    unsigned sum, cnt, mine, sp = 0u;
    for (;;) {
        sum = 0u; cnt = 0u; mine = 0u;
#pragma unroll
        for (unsigned j = 0; j < 16; ++j) { const unsigned c = xb_ld(&bar[XB_XCNT(j)]); sum += c; cnt += (c > 0u) ? 1u : 0u; mine = (j == x) ? c : mine; }
        if (sum == G) break;
        __builtin_amdgcn_s_sleep(1);
        if ((++sp & 255u) == 0u) { if (xb_ld(&bar[XB_TMO])) break; if (sp > XB_SPIN_CAP) { atomicAdd(&bar[XB_TMO], 1u); break; } }
    }
    nloc = mine > 0u ? mine : 1u; nx = cnt > 0u ? cnt : 1u;
}

__device__ __forceinline__ void xcd_barrier(const XcdBarrier& b, int tid_b) {
    asm volatile("s_waitcnt vmcnt(0)" ::: "memory");
    __syncthreads();
    if (tid_b == 0) {
        unsigned* bar = b.bar;
        __builtin_amdgcn_s_waitcnt(0);
        unsigned nloc = b.st[0], nx = b.st[1];
        if (nloc == 0u) { xcd_barrier_complete(bar, b.x, nloc, nx); b.st[0] = nloc; b.st[1] = nx; }
        const unsigned old = xb_add(&bar[XB_XSUB(b.x)], 1u);
        const unsigned gen = old / nloc;
        if (old + 1u == (gen + 1u) * nloc) {
            __builtin_amdgcn_fence(__ATOMIC_RELEASE, "agent");
            asm volatile("s_waitcnt vmcnt(0)" ::: "memory");
            const unsigned og = xb_add(&bar[XB_TOP], 1u);
            const unsigned tg = og / nx;
            if (og + 1u == (tg + 1u) * nx) xb_add(&bar[XB_TOPGEN], 1u);
            else XB_SPIN(xb_ld(&bar[XB_TOPGEN]) == tg, bar);
            __builtin_amdgcn_fence(__ATOMIC_ACQUIRE, "agent");
            xb_add(&bar[XB_XGEN(b.x)], 1u);
            asm volatile("s_waitcnt vmcnt(0)" ::: "memory");
        } else {
            XB_SPIN(xb_ld(&bar[XB_XGEN(b.x)]) == gen, bar);
            __builtin_amdgcn_fence(__ATOMIC_ACQUIRE, "agent");
            asm volatile("s_waitcnt vmcnt(0)" ::: "memory");
        }
    }
    __syncthreads();
}


__device__ __forceinline__ int hw_lane() { int l; asm volatile("v_mbcnt_lo_u32_b32 %0, -1, 0\n\tv_mbcnt_hi_u32_b32 %0, -1, %0" : "=v"(l)); return l; }
__device__ __forceinline__ float bf2f(bf16 u) { return __builtin_bit_cast(float, (unsigned)u << 16); }
__device__ __forceinline__ float wave_sum(float v, int lane) {
    v += sx<1>(v, lane); v += sx<2>(v, lane); v += sx<4>(v, lane); v += sx<8>(v, lane); v += sx<16>(v, lane); v += sx<32>(v, lane);
    return v;
}
__device__ __forceinline__ float sigmoidf_(float x) { return __builtin_amdgcn_rcpf(1.0f + __builtin_amdgcn_exp2f(-1.4426950408889634f * x)); }
__device__ __forceinline__ float block_sum(float v, LAS float* buf, int wave, int lane) {
    v = wave_sum(v, lane); if (lane == 0) buf[wave] = v; __syncthreads();
    float s = 0.f;
#pragma unroll
    for (int i = 0; i < NWAVES; ++i) s += buf[i];
    __syncthreads(); return s;
}

__device__ __forceinline__ void tr_item(const float* W, int ldw, int c0, const float* gs, bf16* WT, int ldk, int drow, LAS float* scr, int k0, int n0, int lane) {
    const float* src = W + (size_t)(k0 + (lane >> 5)) * ldw + c0 + n0 + (lane & 31); float v[32];
    const float g = gs ? gs[k0 + lane] : 1.0f;
#pragma unroll
    for (int i = 0; i < 32; ++i) v[i] = __builtin_nontemporal_load(src + (size_t)(2 * i) * ldw);
#pragma unroll
    for (int i = 0; i < 32; ++i) { const float g0 = __builtin_bit_cast(float, __builtin_amdgcn_readlane(__builtin_bit_cast(int, g), 2 * i)), g1 = __builtin_bit_cast(float, __builtin_amdgcn_readlane(__builtin_bit_cast(int, g), 2 * i + 1));
        scr[(2 * i + (lane >> 5)) * 33 + (lane & 31)] = v[i] * (lane < 32 ? g0 : g1); }
    LDS_WAIT(); asm volatile("" ::: "memory");
    const int c = lane & 7;
#pragma unroll
    for (int j = 0; j < 4; ++j) { const int n = (lane >> 3) + 8 * j; const LAS float* s = scr + (8 * c) * 33 + n;
        v4u o; o.x = pk2(s[0 * 33], s[1 * 33]); o.y = pk2(s[2 * 33], s[3 * 33]); o.z = pk2(s[4 * 33], s[5 * 33]); o.w = pk2(s[6 * 33], s[7 * 33]);
        *(GAS v4u*)(WT + (size_t)(drow + n0 + n) * ldk + k0 + 8 * c) = o; }
    LDS_WAIT(); asm volatile("" ::: "memory");
}
typedef const __attribute__((address_space(4))) char* kaptr_t;
__device__ __forceinline__ kaptr_t karg() { kaptr_t p = (kaptr_t)__builtin_amdgcn_kernarg_segment_ptr(); asm volatile("" : "+s"(p)); return p; }
struct Ptrs {
    __device__ __forceinline__ const float* in(int k) const { return *(const float* const __attribute__((address_space(4)))*)(karg() + 8 * k); }
#define PF(name, k) __device__ __forceinline__ const float* name() const { return in(k); }
    PF(x, 0) PF(g_mix, 1) PF(g_ffn, 2) PF(g_fin, 3) PF(ev_w_in, 4) PF(ev_cw, 5) PF(ev_cb, 6) PF(ev_ib, 7) PF(ev_fb, 8) PF(ev_ngm, 9) PF(ev_ngr, 10) PF(ev_w_out, 11)
    PF(od_w_in, 12) PF(od_pw, 13) PF(od_ps, 14) PF(od_dw, 15) PF(od_db, 16) PF(od_ng, 17) PF(od_nb, 18) PF(od_w_out, 19) PF(w_gate, 20) PF(w_up, 21) PF(w_down, 22)
#undef PF
    __device__ __forceinline__ float* out() const { return *(float* const __attribute__((address_space(4)))*)(karg() + 184); }
    __device__ __forceinline__ unsigned char* ws() const { return *(unsigned char* const __attribute__((address_space(4)))*)(karg() + 192); }
    __device__ __forceinline__ int ph_lo() const { return *(const __attribute__((address_space(4))) int*)(karg() + 200); }
    __device__ __forceinline__ int ph_hi() const { return *(const __attribute__((address_space(4))) int*)(karg() + 204); }
};
__device__ __forceinline__ void cv_in(const Ptrs& P, int L, LAS float* scr, int gw, int NGW, int lane) {
    const int j = L >> 1; const bool even = (L & 1) == 0; const float* gm = P.g_mix() + L * D;
    bf16* WIN = (bf16*)(P.ws() + (even ? WS_WIN_A : WS_WIN_B));
    const float* Win = even ? P.ev_w_in() + (size_t)j * D * EV_IN : P.od_w_in() + (size_t)j * D * OD_N;
    const int ldin = even ? EV_IN : OD_N, nblk = even ? 64 : 48, I_INA = 16 * nblk, I_INB = even ? 16 * 64 : 0;
    for (int it = gw; it < I_INA + I_INB; it += NGW) {
        if (it < I_INA) tr_item(Win, ldin, 0, gm, WIN, D, 0, scr, 64 * (it / nblk), 32 * (it % nblk), lane);
        else { const int r = it - I_INA; tr_item(Win, ldin, 2056, gm, WIN, D, 2048, scr, 64 * (r / 64), 32 * (r % 64), lane); } }
    if (even) { bf16* WTG = (bf16*)(P.ws() + WS_WTG);
#pragma clang loop vectorize(disable) unroll(disable)
        for (int idx = gw * 64 + lane; idx < 8 * D; idx += NGW * 64) { const int c = idx >> 10, k = idx & 1023; WTG[idx] = (bf16)f2bf(gm[k] * Win[(size_t)k * EV_IN + 2048 + c]); } }
}
__device__ __forceinline__ void cv_out(const Ptrs& P, int L, LAS float* scr, int gw, int NGW, int lane) {
    const int j = L >> 1; const bool even = (L & 1) == 0;
    const float* Wout = even ? P.ev_w_out() + (size_t)j * D * D : P.od_w_out() + (size_t)j * D * D; bf16* WOUT = (bf16*)(P.ws() + WS_WOUT) + (size_t)L * D * D;
    const int I_OUT = 16 * 32, I_POOL = even ? 0 : 32;
    for (int it = gw; it < I_OUT + I_POOL; it += NGW) {
        if (it < I_OUT) tr_item(Wout, D, 0, nullptr, WOUT, D, 0, scr, 64 * (it / 32), 32 * (it % 32), lane);
        else { const int r = it - I_OUT, g = r >> 3, q = r & 7; tr_item(P.od_pw() + (size_t)(j * 4 + g) * 128 * 128, 128, 0, nullptr, (bf16*)(P.ws() + WS_WTP) + g * 128 * 128, 128, 0, scr, 64 * (q >> 2), 32 * (q & 3), lane); } }
}
__device__ __forceinline__ void cv_ffn(const Ptrs& P, int L, LAS float* scr, int gw, int NGW, int lane) {
    const bool even = (L & 1) == 0; const float* gf = P.g_ffn() + L * D;
    bf16* WGU = (bf16*)(P.ws() + (even ? WS_WGU_A : WS_WGU_B)); bf16* WD = (bf16*)(P.ws() + (even ? WS_WD_A : WS_WD_B));
    const float* Wg = P.w_gate() + (size_t)L * D * DFF; const float* Wu = P.w_up() + (size_t)L * D * DFF; const float* Wd = P.w_down() + (size_t)L * DFF * D;
    const int I_G = 16 * 88, I_D = 44 * 32;
    for (int it = gw; it < 2 * I_G + I_D; it += NGW) {
        if (it < 2 * I_G) { const int up = it >= I_G, r = it - up * I_G, n0 = 32 * (r % 88); tr_item(up ? Wu : Wg, DFF, 0, gf, WGU, D, (n0 >> 7) * 256 + (n0 & 127) + up * 128 - n0, scr, 64 * (r / 88), n0, lane); }
        else { const int r = it - 2 * I_G; tr_item(Wd, D, 0, nullptr, WD, DFF, 0, scr, 64 * (r / 32), 32 * (r % 32), lane); } }
}
__device__ __forceinline__ void prologue_rows(const Ptrs& P, int gw, int NGW, int lane) {
    bf16* XB = (bf16*)(P.ws() + WS_XB); float* SSQ = (float*)(P.ws() + WS_SSQ); float* ROT = (float*)(P.ws() + WS_ROT);
    for (int m = gw; m < M; m += NGW) {
        const GAS f32x4* xr = (const GAS f32x4*)(P.x() + (size_t)m * D) + lane; GAS unsigned long long* o8 = (GAS unsigned long long*)(XB + (size_t)m * D) + lane;
        float s = 0.f;
#pragma unroll
        for (int q = 0; q < 4; ++q) { const f32x4 v = xr[64 * q]; s += (v.x * v.x + v.y * v.y) + (v.z * v.z + v.w * v.w); o8[64 * q] = (unsigned long long)pk2(v.x, v.y) | ((unsigned long long)pk2(v.z, v.w) << 32); }
        s = wave_sum(s, lane);
        if (lane < 16) SSQ[(size_t)m * 16 + lane] = lane == 0 ? s : 0.f;
    }
    for (int t = gw; t < SEQ; t += NGW) {
        const float inv = powf(10000.0f, -(float)(2 * lane) / 128.0f); const float ang = (float)t * inv; float sn, cs; sincosf(ang, &sn, &cs);
        ROT[((size_t)t * 64 + lane) * 2] = cs; ROT[((size_t)t * 64 + lane) * 2 + 1] = sn;
    }
}
__device__ __forceinline__ void final_norm(const Ptrs& P, int gw, int NGW, int lane) {
    const bf16* XBp = (const bf16*)(P.ws() + WS_XB);
    for (int m = gw; m < M; m += NGW) {
        const GAS v4u* xr = (const GAS v4u*)(XBp + (size_t)m * D) + lane; GAS f32x4* orow = (GAS f32x4*)(P.out() + (size_t)m * D); const GAS f32x4* gr = (const GAS f32x4*)P.g_fin();
        float v[16]; float s = 0.f;
#pragma unroll
        for (int q = 0; q < 2; ++q) { const v4u w = xr[64 * q];
#pragma unroll
            for (int e = 0; e < 4; ++e) { v[8 * q + 2 * e] = __builtin_bit_cast(float, w[e] << 16); v[8 * q + 2 * e + 1] = __builtin_bit_cast(float, w[e] & 0xffff0000u); } }
#pragma unroll
        for (int k = 0; k < 16; ++k) s += v[k] * v[k];
        const float rs = __builtin_amdgcn_rsqf(wave_sum(s, lane) * (1.0f / D) + EPS);
#pragma unroll
        for (int q = 0; q < 2; ++q)
#pragma unroll
            for (int hq = 0; hq < 2; ++hq) { const int idx = 2 * (lane + 64 * q) + hq; const f32x4 g = gr[idx];
                orow[idx] = (f32x4){v[8 * q + 4 * hq] * rs * g.x, v[8 * q + 4 * hq + 1] * rs * g.y, v[8 * q + 4 * hq + 2] * rs * g.z, v[8 * q + 4 * hq + 3] * rs * g.w}; }
    }
}
__device__ __forceinline__ void gates_rows(const Ptrs& P, int j, int gw, int NGW, int lane) {
    const bf16* XB = (const bf16*)(P.ws() + WS_XB); const bf16* WTG = (const bf16*)(P.ws() + WS_WTG); const float* SSQ = (const float*)(P.ws() + WS_SSQ); float* GATES = (float*)(P.ws() + WS_GATES);
    const int r16 = lane & 15, kq = lane >> 4; const float bias = r16 < 4 ? P.ev_ib()[j * 4 + r16] : (r16 < 8 ? P.ev_fb()[j * 4 + r16 - 4] : 0.f);
    for (int grp = gw; grp < M / 16; grp += NGW) {
        const GAS v4u* a = (const GAS v4u*)(XB + (size_t)(grp * 16 + r16) * D + 8 * kq); const GAS v4u* w = (const GAS v4u*)(WTG + (size_t)(r16 & 7) * D + 8 * kq);
        pg8::f32x4 acc = (pg8::f32x4){0.f, 0.f, 0.f, 0.f};
#pragma unroll 8
        for (int s2 = 0; s2 < D / 32; ++s2) { const v4u av = a[4 * s2]; v4u wv = w[4 * s2]; if (r16 >= 8) wv = (v4u){0u, 0u, 0u, 0u};
            acc = __builtin_amdgcn_mfma_f32_16x16x32_bf16(__builtin_bit_cast(bf16x8, av), __builtin_bit_cast(bf16x8, wv), acc, 0, 0, 0); }
        const f32x4 p = *(const GAS f32x4*)(SSQ + (size_t)(grp * 16 + r16) * 16 + 4 * kq); float sq = (p.x + p.y) + (p.z + p.w);
        sq += sx<16>(sq, lane); sq += sx<32>(sq, lane);
        const float rs = __builtin_amdgcn_rsqf(sq * (1.0f / D) + EPS);
#pragma unroll
        for (int e = 0; e < 4; ++e) { const float rr = __builtin_bit_cast(float, __builtin_amdgcn_ds_bpermute((4 * kq + e) << 2, __builtin_bit_cast(int, rs)));
            if (r16 < 8) GATES[(size_t)(grp * 16 + 4 * kq + e) * 8 + r16] = acc[e] * rr + bias; }
    }
}

typedef float f32x2v __attribute__((ext_vector_type(2)));
typedef float f32x16 __attribute__((ext_vector_type(16)));
__device__ __forceinline__ f32x2v unpk2(unsigned w) { f32x2v r; r.x = __builtin_bit_cast(float, w << 16); r.y = __builtin_bit_cast(float, w & 0xffff0000u); return r; }
__device__ __forceinline__ int crow(int reg, int h) { return (reg & 3) + 8 * (reg >> 2) + 4 * h; }
template <int N, int DIST> __device__ __forceinline__ void bfly_step(const float (&v)[N], float (&r)[N / 2], int lane) {
    const bool up = (lane & DIST) != 0;
#pragma unroll
    for (int i = 0; i < N / 2; ++i) { const float send = up ? v[i] : v[i + N / 2], keep = up ? v[i + N / 2] : v[i]; r[i] = keep + sx<DIST>(send, lane); }
}
__device__ __forceinline__ float bfly32(const float (&v)[32], int lane) {
    float a[16], b[8], c[4], d[2], e[1];
    bfly_step<32, 32>(v, a, lane); bfly_step<16, 16>(a, b, lane); bfly_step<8, 8>(b, c, lane); bfly_step<4, 4>(c, d, lane); bfly_step<2, 2>(d, e, lane);
    return e[0] + sx<1>(e[0], lane);
}
constexpr int OD_Y_ROWS = 94, OD_U_ROWS = 79, OD_WP_OFF = OD_Y_ROWS * 1024, OD_MS_OFF = OD_WP_OFF + 2048, OD_PL_STRIDE = 1040;
__device__ __forceinline__ void od_fast_item(const Ptrs& P, int j, LAS unsigned char* lds, int item, int tid_in) {
    int tid = tid_in; asm volatile("" : "+v"(tid));
    const bf16* Z = (const bf16*)(P.ws() + WS_Z); bf16* MIXED = (bf16*)(P.ws() + WS_MIXED);
    const int row0 = item * 64, t0 = row0 & (SEQ - 1), lane = tid & 63, wv = tid >> 6;
    const bf16* zt = Z + (size_t)row0 * OD_N;
    for (int idx = tid; idx < OD_Y_ROWS * 64; idx += NWAVES * 64) { const int r = idx >> 6, ch = idx & 63, trel = r - 30; v4u o = (v4u){0u, 0u, 0u, 0u};
        if (t0 + trel >= 0) { const bf16* zr = zt + (long)trel * OD_N + 8 * ch; const v4u ga = *(const GAS v4u*)(zr + 512), gb = *(const GAS v4u*)(zr + 1024);
#pragma unroll
            for (int e = 0; e < 4; ++e) { const f32x2v a = unpk2(ga[e]), b = unpk2(gb[e]); o[e] = pk2(a.x * sigmoidf_(b.x), a.y * sigmoidf_(b.y)); } }
        *(LAS v4u*)(lds + r * 1024 + ch * 16) = o; }
    __syncthreads();
    const int cp = tid & 255, th = tid >> 8;
    f32x2v acc[32];
    {
        const float* dw = P.od_dw() + (size_t)j * 31 * 512 + 2 * cp; f32x2v w[31];
#pragma unroll
        for (int k = 0; k < 31; ++k) w[k] = *(const GAS f32x2v*)(dw + k * 512);
        const f32x2v bias = *(const GAS f32x2v*)(P.od_db() + j * 512 + 2 * cp);
#pragma unroll
        for (int t = 0; t < 32; ++t) acc[t] = bias;
        const LAS unsigned char* yb = lds + (32 * th) * 1024 + 4 * cp;
#pragma unroll
        for (int r = 0; r < 62; ++r) { const f32x2v y = unpk2(*(const LAS unsigned*)(yb + r * 1024));
#pragma unroll
            for (int t = (r > 30 ? r - 30 : 0); t <= (r < 31 ? r : 31); ++t) acc[t] += w[r - t] * y;
            if ((r & 3) == 3) asm volatile("" ::: "memory"); }
    }
    {
        float s1[32], s2[32];
#pragma unroll
        for (int t = 0; t < 32; ++t) { s1[t] = acc[t].x + acc[t].y; s2[t] = acc[t].x * acc[t].x + acc[t].y * acc[t].y; }
        const float t1 = bfly32(s1, lane), t2 = bfly32(s2, lane);
        if ((lane & 1) == 0) *(LAS f32x2v*)(lds + OD_WP_OFF + (wv * 32 + (lane >> 1)) * 8) = (f32x2v){t1, t2};
    }
    __syncthreads();
    if (tid < 64) { const int th_ = tid >> 5, tk = tid & 31; f32x2v a = (f32x2v){0.f, 0.f};
#pragma unroll
        for (int w4 = 0; w4 < 4; ++w4) a += *(const LAS f32x2v*)(lds + OD_WP_OFF + ((th_ * 4 + w4) * 32 + tk) * 8);
        const float mean = a.x * (1.0f / 512.0f), var = fmaxf(a.y * (1.0f / 512.0f) - mean * mean, 0.f);
        *(LAS f32x2v*)(lds + OD_MS_OFF + tid * 8) = (f32x2v){mean, __builtin_amdgcn_rsqf(var + EPS)}; }
    __syncthreads();
    {
        const f32x2v g2 = *(const GAS f32x2v*)(P.od_ng() + j * 512 + 2 * cp), b2 = *(const GAS f32x2v*)(P.od_nb() + j * 512 + 2 * cp);
        bf16* mo = MIXED + (size_t)(row0 + 32 * th) * D + 512 + 2 * cp; const LAS unsigned char* msb = lds + OD_MS_OFF + (32 * th) * 8;
#pragma unroll
        for (int t = 0; t < 32; ++t) { const f32x2v ms = *(const LAS f32x2v*)(msb + t * 8);
            f32x2v y = (acc[t] - ms.x) * ms.y * g2 + b2; y.x *= sigmoidf_(y.x); y.y *= sigmoidf_(y.y);
            *(GAS unsigned*)mo = pk2(y.x, y.y); mo += D; asm volatile("" : "+v"(mo)); }
    }
    for (int idx = tid; idx < OD_U_ROWS * 64; idx += NWAVES * 64) { const int r = idx >> 6, ch = idx & 63, trel = r - 15; v4u o = (v4u){0u, 0u, 0u, 0u};
        if (t0 + trel >= 0) o = *(const GAS v4u*)(zt + (long)trel * OD_N + 8 * ch);
        *(LAS v4u*)(lds + r * 1024 + ch * 16) = o; }
    __syncthreads();
    {
        const int w = 2 << (cp >> 6); f32x2v S = (f32x2v){0.f, 0.f}, pooled[32];
        const LAS unsigned char* pb = lds + (32 * th + 15) * 1024 + 4 * cp; const LAS unsigned char* pwb = pb - w * 1024;
        for (int k = 0; k < w; ++k) S += unpk2(*(const LAS unsigned*)(pb - k * 1024));
#pragma unroll
        for (int t = 0; t < 32; ++t) { const f32x2v cur = unpk2(*(const LAS unsigned*)(pb + t * 1024));
            if (t > 0) S += cur - unpk2(*(const LAS unsigned*)(pwb + t * 1024));
            const int tp1 = t0 + 32 * th + t + 1; const float ic = __builtin_amdgcn_rcpf((float)(tp1 < w ? tp1 : w));
            pooled[t] = S * ic - cur; }
        __syncthreads();
        { LAS unsigned char* plb = lds + (32 * th) * OD_PL_STRIDE + 4 * cp;
#pragma unroll
        for (int t = 0; t < 32; ++t) *(LAS unsigned*)(plb + t * OD_PL_STRIDE) = pk2(pooled[t].x, pooled[t].y); }
    }
    __syncthreads();
    {
        const int g = wv >> 1, tt = wv & 1, r = lane & 31, hh = lane >> 5;
        const bf16* WTP = (const bf16*)(P.ws() + WS_WTP) + (size_t)g * 128 * 128;
        f32x16 c4[4];
#pragma unroll
        for (int ot = 0; ot < 4; ++ot)
#pragma unroll
            for (int i = 0; i < 16; ++i) c4[ot][i] = 0.f;
#pragma unroll
        for (int s = 0; s < 8; ++s) { const bf16x8 a = *(const LAS bf16x8*)(lds + (32 * tt + r) * OD_PL_STRIDE + g * 256 + s * 32 + hh * 16);
#pragma unroll
            for (int ot = 0; ot < 4; ++ot) { const bf16x8 b = *(const GAS bf16x8*)(WTP + (size_t)(32 * ot + r) * 128 + 16 * s + 8 * hh);
                c4[ot] = __builtin_amdgcn_mfma_f32_32x32x16_bf16(a, b, c4[ot], 0, 0, 0); } }
#pragma unroll
        for (int ot = 0; ot < 4; ++ot) { const float ps = P.od_ps()[j * 512 + g * 128 + 32 * ot + r];
#pragma unroll
            for (int i = 0; i < 16; ++i) { bf16* q = MIXED + (size_t)(row0 + 32 * tt + 4 * hh) * D + g * 128 + 32 * ot + r; asm volatile("" : "+v"(q)); q[(size_t)((i & 3) + 8 * (i >> 2)) * D] = (bf16)f2bf(c4[ot][i] * ps); } }
    }
    __syncthreads();
}

typedef short v4i16_t __attribute__((ext_vector_type(4)));
typedef unsigned u32x2 __attribute__((ext_vector_type(2)));
constexpr int EV_Q = 0, EV_K = 32768, EV_VT = 65536, EV_CT = 98304, EV_SC = 132096;
constexpr int SC_G = 0, SC_RF = 512, SC_INT = 1024, SC_EMM = 1536, SC_PAR = 2048, SC_QN = 4096, SC_N = 4608, SC_NP = 5120, SC_SS = 9216;
__device__ __forceinline__ unsigned offb(unsigned row, unsigned ch) { return 256u * row + 16u * (ch ^ (((row & 3u) << 2) | ((row >> 2) & 3u))); }
__device__ __forceinline__ bf16x8 tr_frag(LAS unsigned char* img, int lane, int c, int ks) {
    const unsigned h = lane >> 5, blk = (lane >> 4) & 1, q = (lane & 15) >> 2, p = lane & 3;
    const v4i16_t lo = __builtin_amdgcn_ds_read_tr16_b64_v4i16((LAS v4i16_t*)(img + offb(16 * ks + 8 * h + q, 4 * c + 2 * blk + (p >> 1)) + 8 * (p & 1)));
    const v4i16_t hi = __builtin_amdgcn_ds_read_tr16_b64_v4i16((LAS v4i16_t*)(img + offb(16 * ks + 8 * h + 4 + q, 4 * c + 2 * blk + (p >> 1)) + 8 * (p & 1)));
    return (bf16x8){lo[0], lo[1], lo[2], lo[3], hi[0], hi[1], hi[2], hi[3]};
}
__device__ __forceinline__ void unpk8(const v4u w, float (&o)[8]) {
#pragma unroll
    for (int e = 0; e < 4; ++e) { o[2 * e] = __builtin_bit_cast(float, w[e] << 16); o[2 * e + 1] = __builtin_bit_cast(float, w[e] & 0xffff0000u); }
}
__device__ __forceinline__ v4u pk8(const float (&o)[8]) { v4u w; w.x = pk2(o[0], o[1]); w.y = pk2(o[2], o[3]); w.z = pk2(o[4], o[5]); w.w = pk2(o[6], o[7]); return w; }
__device__ __forceinline__ float siluf_(float x) { return x * sigmoidf_(x); }
constexpr int SC_WL = 9232, SC_NG = SC_WL + 5120;
__device__ __forceinline__ void conv4_silu_pre(const v4u (&raw)[7], const LAS unsigned char* wl, int dc, float (&out)[4][8]) {
    float w[5][8];
#pragma unroll
    for (int tap = 0; tap < 5; ++tap) { const f32x4 a = *(const LAS f32x4*)(wl + (tap * 128 + 8 * dc) * 4), b = *(const LAS f32x4*)(wl + (tap * 128 + 8 * dc + 4) * 4);
        w[tap][0] = a.x; w[tap][1] = a.y; w[tap][2] = a.z; w[tap][3] = a.w; w[tap][4] = b.x; w[tap][5] = b.y; w[tap][6] = b.z; w[tap][7] = b.w; }
#pragma unroll
    for (int jj = 0; jj < 4; ++jj)
#pragma unroll
        for (int e = 0; e < 8; ++e) out[jj][e] = w[4][e];
#pragma unroll
    for (int rr = 0; rr < 7; ++rr) { float x[8]; unpk8(raw[rr], x);
#pragma unroll
        for (int jj = 0; jj < 4; ++jj) { const int tap = rr - jj; if (tap >= 0 && tap < 4) {
#pragma unroll
            for (int e = 0; e < 8; ++e) out[jj][e] += w[tap][e] * x[e]; } } }
#pragma unroll
    for (int jj = 0; jj < 4; ++jj)
#pragma unroll
        for (int e = 0; e < 8; ++e) out[jj][e] = siluf_(out[jj][e]);
}
__device__ __forceinline__ void rot4_pre(const v4u (&raw)[4], const f32x4 (&cs)[16], int dc, int lane, float (&out)[4][8]) {
#pragma unroll
    for (int jj = 0; jj < 4; ++jj) { v4u pr; pr.x = sxu<8>(raw[jj].x, lane); pr.y = sxu<8>(raw[jj].y, lane); pr.z = sxu<8>(raw[jj].z, lane); pr.w = sxu<8>(raw[jj].w, lane);
        float x[8], xp[8]; unpk8(raw[jj], x); unpk8(pr, xp);
#pragma unroll
        for (int e2 = 0; e2 < 4; ++e2) { const f32x4 c4 = cs[4 * jj + e2];
            out[jj][2 * e2] = dc < 8 ? x[2 * e2] * c4.x - xp[2 * e2] * c4.y : xp[2 * e2] * c4.y + x[2 * e2] * c4.x;
            out[jj][2 * e2 + 1] = dc < 8 ? x[2 * e2 + 1] * c4.z - xp[2 * e2 + 1] * c4.w : xp[2 * e2 + 1] * c4.w + x[2 * e2 + 1] * c4.z; } }
}
template <bool RET>
__device__ __forceinline__ void ev_fast_item(const Ptrs& P, int jl, LAS unsigned char* lds, int item, int tid_in) {
    int tid0 = tid_in; asm volatile("" : "+v"(tid0));
    const bf16* Z = (const bf16*)(P.ws() + WS_Z);
    const int b = (item >> 2) & 7, h = item & 3;
    LAS unsigned char* sc = lds + EV_SC;
    constexpr int NRAW = RET ? 4 : 7;
    constexpr int COL_K = RET ? 2560 : 512, COL_Q = RET ? 2048 : 0, COL_V = RET ? 3072 : 1024, COL_G = RET ? 3584 : 1536;
    for (int k = tid0 * 16; k < 32768; k += NWAVES * 64 * 16) *(LAS v4u*)(lds + EV_CT + k) = (v4u){0u, 0u, 0u, 0u};
    if (tid0 < 128) { *(LAS float*)(sc + SC_N + 4 * tid0) = 0.f; *(LAS float*)(sc + SC_NG + 4 * tid0) = (RET ? P.ev_ngr() : P.ev_ngm())[jl * 512 + h * 128 + tid0]; }
    if (!RET && tid0 < 256) { const int isq = tid0 >> 7, d = tid0 & 127, ch = (isq ? 512 : 0) + h * 128 + d; const float* cw = P.ev_cw() + (size_t)jl * 4096;
#pragma unroll
        for (int tap = 0; tap < 4; ++tap) *(LAS float*)(sc + SC_WL + ((isq * 5 + tap) * 128 + d) * 4) = cw[tap * 1024 + ch];
        *(LAS float*)(sc + SC_WL + ((isq * 5 + 4) * 128 + d) * 4) = P.ev_cb()[jl * 1024 + ch]; }
    if (RET && tid0 < 128) { const float lg = __logf(1.0f - exp2f(-5.0f - (float)h));
#pragma unroll
        for (int p = 0; p < 2; ++p) { LAS unsigned char* s = sc + p * SC_PAR;
            *(LAS float*)(s + SC_G + 4 * tid0) = __expf(lg * (float)(127 - tid0)); *(LAS float*)(s + SC_RF + 4 * tid0) = __expf(lg * (float)(tid0 - 127));
            *(LAS float*)(s + SC_INT + 4 * tid0) = __expf(lg * (float)(tid0 + 1));
            if (tid0 == 0) { float one = 1.0f; asm volatile("" : "+v"(one)); *(LAS float*)(sc + SC_SS + 8 * p) = __expf(lg * 128.0f); *(LAS float*)(sc + SC_SS + 8 * p + 4) = one; } } }
    f32x16 Cst[2];
#pragma unroll
    for (int t = 0; t < 2; ++t)
#pragma unroll
        for (int i = 0; i < 16; ++i) Cst[t][i] = 0.f;
    v4u pk[NRAW], pq[NRAW], pv[4]; float gpre[4] = {0.f, 0.f, 0.f, 0.f};
    float m_prev = -1e30f;
    const float* GATES = (const float*)(P.ws() + WS_GATES);
#define EV_LD(ub, voff) (*(const GAS v4u*)((const GAS char*)(ub) + (size_t)(unsigned)(voff)))
#define EV_PREFETCH(cc) do { const int jg_ = tid0 >> 4, dc_ = tid0 & 15, j0_ = 4 * jg_; const unsigned voff_ = (unsigned)(j0_ * EV_N + 8 * dc_) * 2u; \
        const bf16* zu = Z + ((size_t)b * SEQ + (size_t)(cc) * CHUNK) * EV_N + h * 128;     \
        if constexpr (!RET) { _Pragma("unroll") for (int rr = 0; rr < 7; ++rr) { \
                if ((cc) == 0 && j0_ - 3 + rr < 0) { pk[rr] = (v4u){0u, 0u, 0u, 0u}; pq[rr] = (v4u){0u, 0u, 0u, 0u}; } else { pk[rr] = EV_LD(zu + (long)(rr - 3) * EV_N + COL_K, voff_); pq[rr] = EV_LD(zu + (long)(rr - 3) * EV_N + COL_Q, voff_); } } } \
        else { _Pragma("unroll") for (int jj = 0; jj < 4; ++jj) { pk[jj] = EV_LD(zu + (long)jj * EV_N + COL_K, voff_); pq[jj] = EV_LD(zu + (long)jj * EV_N + COL_Q, voff_); } } \
        _Pragma("unroll") for (int jj = 0; jj < 4; ++jj) pv[jj] = EV_LD(zu + (long)jj * EV_N + COL_V, voff_); } while (0)
#define EV_GATES_PREFETCH(cc) do { const float* gp = GATES + ((size_t)b * SEQ + (size_t)(cc) * CHUNK + 2 * (tid0 & 63)) * 8; gpre[0] = gp[h]; gpre[1] = gp[4 + h]; gpre[2] = gp[8 + h]; gpre[3] = gp[12 + h]; } while (0)
#define EV_STEP0(cc) do { const int lane_ = tid0 & 63; LAS unsigned char* sq = sc + ((cc) & 1) * SC_PAR; \
        const float ip0 = gpre[0], fp0 = gpre[1], ip1 = gpre[2], fp1 = gpre[3]; \
        const float lf0 = fminf(fp0, 0.f) - log1pf(__expf(-fabsf(fp0))), lf1 = fminf(fp1, 0.f) - log1pf(__expf(-fabsf(fp1))); \
        const float c1 = lf0 + lf1; float tot = c1; \
        _Pragma("unroll") for (int o = 1; o < 64; o <<= 1) { const float t = shup(tot, o, lane_); if (lane_ >= o) tot += t; } \
        const float ex = tot - c1, b0 = ex + lf0, b1 = ex + c1; \
        const float a0 = ip0 - b0, a1 = ip1 - b1; float pm = fmaxf(a0, a1); \
        _Pragma("unroll") for (int o = 1; o < 64; o <<= 1) { const float t = shup(pm, o, lane_); if (lane_ >= o) pm = fmaxf(pm, t); } \
        float exm = shup(pm, 1, lane_); if (lane_ == 0) exm = -3.0e38f; \
        const float mu0 = fmaxf(exm, a0), mu1 = pm; \
        const float mu127 = __builtin_bit_cast(float, __builtin_amdgcn_readlane(__builtin_bit_cast(int, pm), 63)), total = __builtin_bit_cast(float, __builtin_amdgcn_readlane(__builtin_bit_cast(int, tot), 63)); \
        const float m0 = fmaxf(b0 + mu0, b0 + m_prev), m1 = fmaxf(b1 + mu1, b1 + m_prev); \
        *(LAS f32x2v*)(sq + SC_G + 8 * lane_) = (f32x2v){__expf(a0 - mu127), __expf(a1 - mu127)}; \
        *(LAS f32x2v*)(sq + SC_RF + 8 * lane_) = (f32x2v){__expf(b0 + mu127 - m0), __expf(b1 + mu127 - m1)}; \
        *(LAS f32x2v*)(sq + SC_INT + 8 * lane_) = (f32x2v){__expf(b0 + m_prev - m0), __expf(b1 + m_prev - m1)}; \
        *(LAS f32x2v*)(sq + SC_EMM + 8 * lane_) = (f32x2v){__expf(-m0), __expf(-m1)}; \
        const float m_loc = total + mu127, m_new = fmaxf(total + m_prev, m_loc); \
        if (lane_ == 0) { *(LAS float*)(sc + SC_SS + 8 * ((cc) & 1)) = __expf(total + m_prev - m_new); *(LAS float*)(sc + SC_SS + 8 * ((cc) & 1) + 4) = __expf(m_loc - m_new); } \
        m_prev = m_new; } while (0)
    const int wv0 = __builtin_amdgcn_readfirstlane(tid0 >> 6);
    EV_PREFETCH(0);
    if (!RET && wv0 == 1) { EV_GATES_PREFETCH(0); EV_STEP0(0); EV_GATES_PREFETCH(1); }
    __syncthreads();
    for (int c = 0; c < SEQ / CHUNK; ++c) {
        int tid = tid0; asm volatile("" : "+v"(tid));
        const int lane = tid & 63, wv = __builtin_amdgcn_readfirstlane(tid >> 6), r = lane & 31, hh = lane >> 5;
        const int par = c & 1; LAS unsigned char* scp = sc + par * SC_PAR;
        const size_t rowbase = (size_t)b * SEQ + (size_t)c * CHUNK; const bf16* zc = Z + rowbase * EV_N;
        {
            const int jg = tid >> 4, dc = tid & 15, j0 = 4 * jg; float o4[4][8];
            const f32x4 gj = *(const LAS f32x4*)(scp + SC_G + 16 * jg);
            f32x4 prot[RET ? 16 : 1];
            if constexpr (RET) { const float* rp = (const float*)(P.ws() + WS_ROT) + ((size_t)(c * CHUNK + j0) * 64 + 8 * (dc & 7)) * 2;
#pragma unroll
                for (int jj = 0; jj < 4; ++jj)
#pragma unroll
                    for (int e2 = 0; e2 < 4; ++e2) prot[4 * jj + e2] = *(const GAS f32x4*)(rp + jj * 128 + 4 * e2); }
            if constexpr (!RET) conv4_silu_pre(pk, sc + SC_WL + 5 * 128 * 4, dc, o4); else rot4_pre(pk, prot, dc, lane, o4);
            float ns[8];
#pragma unroll
            for (int e = 0; e < 8; ++e) ns[e] = 0.f;
#pragma unroll
            for (int jj = 0; jj < 4; ++jj) { const float gs = KSCALE * gj[jj];
#pragma unroll
                for (int e = 0; e < 8; ++e) { o4[jj][e] *= gs; ns[e] += o4[jj][e]; }
                *(LAS v4u*)(lds + EV_K + offb(j0 + jj, dc)) = pk8(o4[jj]); }
            if constexpr (!RET) {
#pragma unroll
                for (int e = 0; e < 8; ++e) { ns[e] += sx<16>(ns[e], lane); ns[e] += sx<32>(ns[e], lane); }
                if (lane < 16) { *(LAS f32x4*)(sc + SC_NP + wv * 512 + 32 * dc) = (f32x4){ns[0], ns[1], ns[2], ns[3]}; *(LAS f32x4*)(sc + SC_NP + wv * 512 + 32 * dc + 16) = (f32x4){ns[4], ns[5], ns[6], ns[7]}; }
            }
            if constexpr (!RET) conv4_silu_pre(pq, sc + SC_WL, dc, o4); else rot4_pre(pq, prot, dc, lane, o4);
#pragma unroll
            for (int jj = 0; jj < 4; ++jj) *(LAS v4u*)(lds + EV_Q + offb(j0 + jj, dc)) = pk8(o4[jj]);
#pragma unroll
            for (int e = 0; e < 8; ++e) { unsigned short v4[4];
#pragma unroll
                for (int jj = 0; jj < 4; ++jj) v4[jj] = (unsigned short)((e & 1) ? (pv[jj][e >> 1] >> 16) : (pv[jj][e >> 1] & 0xffffu));
                u32x2 w2; w2.x = (unsigned)v4[0] | ((unsigned)v4[1] << 16); w2.y = (unsigned)v4[2] | ((unsigned)v4[3] << 16);
                *(LAS u32x2*)(lds + EV_VT + offb(8 * dc + e, jg >> 1) + 8 * (jg & 1)) = w2; }
        }
        __syncthreads();
        const int it = wv >> 1, sub = (wv & 1) * 2;
        const float s_old = *(const LAS float*)(sc + SC_SS + 8 * par), s_new = *(const LAS float*)(sc + SC_SS + 8 * par + 4);
        f32x16 Pt[2], Ot[2];
        {
            const float rfi = *(const LAS float*)(scp + SC_RF + 4 * (32 * it + r));
#pragma unroll
            for (int t = 0; t < 2; ++t) { const int jt = sub + t;
#pragma unroll
                for (int i = 0; i < 16; ++i) Pt[t][i] = 0.f;
                if (jt <= it) {
#pragma unroll
                    for (int s = 0; s < 8; ++s) { const bf16x8 a = *(const LAS bf16x8*)(lds + EV_K + offb(32 * jt + r, 2 * s + hh)), bq = *(const LAS bf16x8*)(lds + EV_Q + offb(32 * it + r, 2 * s + hh));
                        Pt[t] = __builtin_amdgcn_mfma_f32_32x32x16_bf16(a, bq, Pt[t], 0, 0, 0); }
#pragma unroll
                    for (int i = 0; i < 16; ++i) { float v = Pt[t][i] * rfi; if (jt == it && crow(i, hh) > r) v = 0.f; Pt[t][i] = v; }
                } }
        }
        if (!RET && wv == 1 && c + 1 < SEQ / CHUNK) { EV_STEP0(c + 1); if (c + 2 < SEQ / CHUNK) EV_GATES_PREFETCH(c + 2); }
        if constexpr (!RET) {
            const int i = tid >> 2, part = tid & 3; float a = 0.f;
#pragma unroll
            for (int cc = 0; cc < 4; ++cc) { float q8[8]; unpk8(*(const LAS v4u*)(lds + EV_Q + offb(i, 4 * part + cc)), q8);
                const f32x4 n0 = *(const LAS f32x4*)(sc + SC_N + 4 * (32 * part + 8 * cc)), n1 = *(const LAS f32x4*)(sc + SC_N + 4 * (32 * part + 8 * cc + 4));
                a += q8[0] * n0.x + q8[1] * n0.y + q8[2] * n0.z + q8[3] * n0.w + q8[4] * n1.x + q8[5] * n1.y + q8[6] * n1.z + q8[7] * n1.w; }
            a += sx<1>(a, lane); a += sx<2>(a, lane);
            if (part == 0) *(LAS float*)(sc + SC_QN + 4 * i) = a;
        }
        {
#pragma unroll
            for (int t = 0; t < 2; ++t) { const int dt = sub + t, vt = it; f32x16 kv;
#pragma unroll
                for (int i = 0; i < 16; ++i) kv[i] = 0.f;
#pragma unroll
                for (int s = 0; s < 8; ++s) { const bf16x8 a = tr_frag(lds + EV_K, lane, dt, s), bv = *(const LAS bf16x8*)(lds + EV_VT + offb(32 * vt + r, 2 * s + hh));
                    kv = __builtin_amdgcn_mfma_f32_32x32x16_bf16(a, bv, kv, 0, 0, 0); }
                const int vt2 = sub + t; f32x16 o;
#pragma unroll
                for (int i = 0; i < 16; ++i) o[i] = 0.f;
#pragma unroll
                for (int s = 0; s < 8; ++s) { const bf16x8 a = *(const LAS bf16x8*)(lds + EV_CT + offb(32 * vt2 + r, 2 * s + hh)), bq = *(const LAS bf16x8*)(lds + EV_Q + offb(32 * it + r, 2 * s + hh));
                    o = __builtin_amdgcn_mfma_f32_32x32x16_bf16(a, bq, o, 0, 0, 0); }
                const float inter = *(const LAS float*)(scp + SC_INT + 4 * (32 * it + r));
#pragma unroll
                for (int i = 0; i < 16; ++i) { Ot[t][i] = o[i] * inter; Cst[t][i] = s_old * Cst[t][i] + s_new * kv[i]; } }
        }
        __syncthreads();
        {
#pragma unroll
            for (int t = 0; t < 2; ++t) { const int jt = sub + t;
                if (jt <= it) {
#pragma unroll
                    for (int q = 0; q < 4; ++q) { u32x2 w2; w2.x = pk2(Pt[t][4 * q], Pt[t][4 * q + 1]); w2.y = pk2(Pt[t][4 * q + 2], Pt[t][4 * q + 3]);
                        *(LAS u32x2*)(lds + EV_K + offb(32 * it + r, 4 * jt + q) + 8 * hh) = w2; } }
                const int dt = sub + t, vt = it;
#pragma unroll
                for (int q = 0; q < 4; ++q) { u32x2 w2; w2.x = pk2(Cst[t][4 * q], Cst[t][4 * q + 1]); w2.y = pk2(Cst[t][4 * q + 2], Cst[t][4 * q + 3]);
                    *(LAS u32x2*)(lds + EV_CT + offb(32 * vt + r, 4 * dt + q) + 8 * hh) = w2; } }
            if (!RET && tid < 128) { float a = 0.f;
#pragma unroll
                for (int w = 0; w < NWAVES; ++w) a += *(const LAS float*)(sc + SC_NP + w * 512 + 4 * tid);
                LAS float* np = (LAS float*)(sc + SC_N + 4 * tid); *np = s_old * *np + s_new * a; }
        }
        __syncthreads();
        const int ei = tid >> 2, epart = tid & 3;
        const bf16* zrow = zc + (size_t)ei * EV_N + COL_G + h * 128 + 32 * epart;
        v4u og[4];
#pragma unroll
        for (int cc = 0; cc < 4; ++cc) og[cc] = *(const GAS v4u*)(zrow + 8 * cc);
        {
#pragma unroll
            for (int t = 0; t < 2; ++t) { const int vt2 = sub + t;
                for (int s = 0; s < 2 * (it + 1); ++s) { const bf16x8 a = *(const LAS bf16x8*)(lds + EV_VT + offb(32 * vt2 + r, 2 * s + hh)), bp = *(const LAS bf16x8*)(lds + EV_K + offb(32 * it + r, 2 * s + hh));
                    Ot[t] = __builtin_amdgcn_mfma_f32_32x32x16_bf16(a, bp, Ot[t], 0, 0, 0); }
#pragma unroll
                for (int q = 0; q < 4; ++q) { u32x2 w2; w2.x = pk2(Ot[t][4 * q], Ot[t][4 * q + 1]); w2.y = pk2(Ot[t][4 * q + 2], Ot[t][4 * q + 3]);
                    *(LAS u32x2*)(lds + EV_Q + offb(32 * it + r, 4 * vt2 + q) + 8 * hh) = w2; } }
        }
        __syncthreads();
        float gate[32];
#pragma unroll
        for (int cc = 0; cc < 4; ++cc) { float o8[8]; unpk8(og[cc], o8);
#pragma unroll
            for (int e = 0; e < 8; ++e) gate[8 * cc + e] = RET ? siluf_(o8[e]) : sigmoidf_(o8[e]); }
        { const int cn = c + 1 < SEQ / CHUNK ? c + 1 : c; EV_PREFETCH(cn); }
        {
            const int i = ei, part = epart; float x[32];
#pragma unroll
            for (int cc = 0; cc < 4; ++cc) { float t8[8]; unpk8(*(const LAS v4u*)(lds + EV_Q + offb(i, 4 * part + cc)), t8);
#pragma unroll
                for (int e = 0; e < 8; ++e) x[8 * cc + e] = t8[e]; }
            if constexpr (!RET) {
                float ps = 0.f;
#pragma unroll
                for (int cc = 0; cc < 4; ++cc) { float t8[8]; unpk8(*(const LAS v4u*)(lds + EV_K + offb(i, 4 * part + cc)), t8);
                    ps += ((t8[0] + t8[1]) + (t8[2] + t8[3])) + ((t8[4] + t8[5]) + (t8[6] + t8[7])); }
                ps = part <= (i >> 5) ? ps : 0.f;
                ps += sx<1>(ps, lane); ps += sx<2>(ps, lane);
                const float den = ps + *(const LAS float*)(scp + SC_INT + 4 * i) * *(const LAS float*)(sc + SC_QN + 4 * i);
                const float inv = __builtin_amdgcn_rcpf(fmaxf(fabsf(den), *(const LAS float*)(scp + SC_EMM + 4 * i)));
#pragma unroll
                for (int k = 0; k < 32; ++k) x[k] *= inv * gate[k];
            }
            float s = 0.f;
#pragma unroll
            for (int k = 0; k < 32; ++k) s += x[k];
            s += sx<1>(s, lane); s += sx<2>(s, lane);
            const float mean = s * (1.0f / 128.0f); float q = 0.f;
#pragma unroll
            for (int k = 0; k < 32; ++k) { x[k] -= mean; q += x[k] * x[k]; }
            q += sx<1>(q, lane); q += sx<2>(q, lane);
            const float rstd = __builtin_amdgcn_rsqf(q * (1.0f / 128.0f) + EPS);
            bf16* mo = (bf16*)(P.ws() + WS_MIXED) + (rowbase + i) * D + (RET ? 512 : 0) + h * 128 + 32 * part;
#pragma unroll
            for (int cc = 0; cc < 4; ++cc) { const f32x4 g0 = *(const LAS f32x4*)(sc + SC_NG + 4 * (32 * part + 8 * cc)), g1 = *(const LAS f32x4*)(sc + SC_NG + 4 * (32 * part + 8 * cc + 4)); float y[8];
                y[0] = x[8 * cc] * rstd * g0.x; y[1] = x[8 * cc + 1] * rstd * g0.y; y[2] = x[8 * cc + 2] * rstd * g0.z; y[3] = x[8 * cc + 3] * rstd * g0.w;
                y[4] = x[8 * cc + 4] * rstd * g1.x; y[5] = x[8 * cc + 5] * rstd * g1.y; y[6] = x[8 * cc + 6] * rstd * g1.z; y[7] = x[8 * cc + 7] * rstd * g1.w;
                if constexpr (RET) {
#pragma unroll
                    for (int e = 0; e < 8; ++e) y[e] *= gate[8 * cc + e]; }
                *(GAS v4u*)(mo + 8 * cc) = pk8(y); }
        }
        __syncthreads();
    }
#undef EV_PREFETCH
#undef EV_LD
#undef EV_GATES_PREFETCH
#undef EV_STEP0
}

constexpr size_t WS_NC = WS_SSQ, WS_SCAL = WS_SSQ + 524288, WS_MPREV = WS_SCAL + 8192;
struct G4 { float a, b, c, d; int h; __device__ __forceinline__ float operator[](int k) const { const int q = (k - h) >> 2; return q == 0 ? a : (q == 1 ? b : (q == 2 ? c : d)); } };
#define EV_SCALARS(FULL, gp_, mprev_, lane_, sq, mloc, tot_out) do { \
        const float ip0 = (gp_)[h], fp0 = (gp_)[4 + h], ip1 = (gp_)[8 + h], fp1 = (gp_)[12 + h]; \
        const float lf0 = fminf(fp0, 0.f) - log1pf(__expf(-fabsf(fp0))), lf1 = fminf(fp1, 0.f) - log1pf(__expf(-fabsf(fp1))); \
        const float c1 = lf0 + lf1; float csum_ = c1; \
        _Pragma("unroll") for (int o = 1; o < 64; o <<= 1) { const float t = shup(csum_, o, lane_); if (lane_ >= o) csum_ += t; } \
        const float ex = csum_ - c1, b0 = ex + lf0, b1 = ex + c1; \
        const float a0 = ip0 - b0, a1 = ip1 - b1; float pm = fmaxf(a0, a1); \
        _Pragma("unroll") for (int o = 1; o < 64; o <<= 1) { const float t = shup(pm, o, lane_); if (lane_ >= o) pm = fmaxf(pm, t); } \
        float exm = shup(pm, 1, lane_); if (lane_ == 0) exm = -3.0e38f; \
        const float mu0 = fmaxf(exm, a0), mu1 = pm; \
        const float mu127 = __builtin_bit_cast(float, __builtin_amdgcn_readlane(__builtin_bit_cast(int, pm), 63)), total = __builtin_bit_cast(float, __builtin_amdgcn_readlane(__builtin_bit_cast(int, csum_), 63)); \
        *(LAS f32x2v*)((sq) + SC_G + 8 * lane_) = (f32x2v){__expf(a0 - mu127), __expf(a1 - mu127)}; \
        if (FULL) { const float m0 = fmaxf(b0 + mu0, b0 + (mprev_)), m1 = fmaxf(b1 + mu1, b1 + (mprev_)); \
            *(LAS f32x2v*)((sq) + SC_RF + 8 * lane_) = (f32x2v){__expf(b0 + mu127 - m0), __expf(b1 + mu127 - m1)}; \
            *(LAS f32x2v*)((sq) + SC_INT + 8 * lane_) = (f32x2v){__expf(b0 + (mprev_) - m0), __expf(b1 + (mprev_) - m1)}; \
            *(LAS f32x2v*)((sq) + SC_EMM + 8 * lane_) = (f32x2v){__expf(-m0), __expf(-m1)}; } \
        mloc = total + mu127; tot_out = total; } while (0)
template <bool RET>
__device__ __forceinline__ void ev_p1_item(const Ptrs& P, int jl, LAS unsigned char* lds, int item, int tid_in) {
    int tid = tid_in; asm volatile("" : "+v"(tid));
    const bf16* Z = (const bf16*)(P.ws() + WS_Z);
    const int hi = item >> 4, c = item & 15, b = (hi >> 2) & 7, h = hi & 3;
    const int lane = tid & 63, wv = __builtin_amdgcn_readfirstlane(tid >> 6), r = lane & 31, hh = lane >> 5;
    LAS unsigned char* sc = lds + EV_SC;
    constexpr int NRAW = RET ? 4 : 7; constexpr int COL_K = RET ? 2560 : 512, COL_V = RET ? 3072 : 1024;
    const size_t rowbase = (size_t)b * SEQ + (size_t)c * CHUNK;
    const int jg = tid >> 4, dc = tid & 15, j0 = 4 * jg; const unsigned voff = (unsigned)(j0 * EV_N + 8 * dc) * 2u;
    const bf16* zu = Z + rowbase * EV_N + h * 128;
#define EV_LD(ub, vo) (*(const GAS v4u*)((const GAS char*)(ub) + (size_t)(unsigned)(vo)))
    G4 gq{0.f, 0.f, 0.f, 0.f, h};
    if constexpr (!RET) { if (wv == 0) { const float* gp = (const float*)(P.ws() + WS_GATES) + (rowbase + 2 * lane) * 8; gq.a = gp[h]; gq.b = gp[4 + h]; gq.c = gp[8 + h]; gq.d = gp[12 + h]; } }
    v4u pk[NRAW], pv[4];
    if constexpr (!RET) {
#pragma unroll
        for (int rr = 0; rr < 7; ++rr) { if (c == 0 && j0 - 3 + rr < 0) pk[rr] = (v4u){0u, 0u, 0u, 0u}; else pk[rr] = EV_LD(zu + (long)(rr - 3) * EV_N + COL_K, voff); }
    } else {
#pragma unroll
        for (int jj = 0; jj < 4; ++jj) pk[jj] = EV_LD(zu + (long)jj * EV_N + COL_K, voff);
    }
#pragma unroll
    for (int jj = 0; jj < 4; ++jj) pv[jj] = EV_LD(zu + (long)jj * EV_N + COL_V, voff);
    if constexpr (!RET) {
        if (wv == 0) { float mloc, tot; EV_SCALARS(false, gq, 0.f, lane, sc, mloc, tot);
            if (lane == 0) { float* sp = (float*)(P.ws() + WS_SCAL) + 2 * item; sp[0] = mloc; sp[1] = tot; } }
        if (tid >= 256) { const int d = tid & 127, ch = 512 + h * 128 + d; const float* cw = P.ev_cw() + (size_t)jl * 4096;
#pragma unroll
            for (int tap = 0; tap < 4; ++tap) *(LAS float*)(sc + SC_WL + ((5 + tap) * 128 + d) * 4) = cw[tap * 1024 + ch];
            *(LAS float*)(sc + SC_WL + ((5 + 4) * 128 + d) * 4) = P.ev_cb()[jl * 1024 + ch]; }
    } else if (tid < 128) { const float lg = __logf(1.0f - exp2f(-5.0f - (float)h)); *(LAS float*)(sc + SC_G + 4 * tid) = __expf(lg * (float)(127 - tid)); }
    __syncthreads();
    {
        float o4[4][8]; const f32x4 gj = *(const LAS f32x4*)(sc + SC_G + 16 * jg);
        f32x4 prot[RET ? 16 : 1];
        if constexpr (RET) { const float* rp = (const float*)(P.ws() + WS_ROT) + ((size_t)(c * CHUNK + j0) * 64 + 8 * (dc & 7)) * 2;
#pragma unroll
            for (int jj = 0; jj < 4; ++jj)
#pragma unroll
                for (int e2 = 0; e2 < 4; ++e2) prot[4 * jj + e2] = *(const GAS f32x4*)(rp + jj * 128 + 4 * e2); }
        if constexpr (!RET) conv4_silu_pre(pk, sc + SC_WL + 5 * 128 * 4, dc, o4); else rot4_pre(pk, prot, dc, lane, o4);
        float ns[8];
#pragma unroll
        for (int e = 0; e < 8; ++e) ns[e] = 0.f;
#pragma unroll
        for (int jj = 0; jj < 4; ++jj) { const float gs = KSCALE * gj[jj];
#pragma unroll
            for (int e = 0; e < 8; ++e) { o4[jj][e] *= gs; ns[e] += o4[jj][e]; }
            *(LAS v4u*)(lds + EV_K + offb(j0 + jj, dc)) = pk8(o4[jj]); }
        if constexpr (!RET) {
#pragma unroll
            for (int e = 0; e < 8; ++e) { ns[e] += sx<16>(ns[e], lane); ns[e] += sx<32>(ns[e], lane); }
            if (lane < 16) { *(LAS f32x4*)(sc + SC_NP + wv * 512 + 32 * dc) = (f32x4){ns[0], ns[1], ns[2], ns[3]}; *(LAS f32x4*)(sc + SC_NP + wv * 512 + 32 * dc + 16) = (f32x4){ns[4], ns[5], ns[6], ns[7]}; }
        }
#pragma unroll
        for (int e = 0; e < 8; ++e) { unsigned short v4[4];
#pragma unroll
            for (int jj = 0; jj < 4; ++jj) v4[jj] = (unsigned short)((e & 1) ? (pv[jj][e >> 1] >> 16) : (pv[jj][e >> 1] & 0xffffu));
            u32x2 w2; w2.x = (unsigned)v4[0] | ((unsigned)v4[1] << 16); w2.y = (unsigned)v4[2] | ((unsigned)v4[3] << 16);
            *(LAS u32x2*)(lds + EV_VT + offb(8 * dc + e, jg >> 1) + 8 * (jg & 1)) = w2; }
    }
    __syncthreads();
    {
        const int it = wv >> 1, sub = (wv & 1) * 2;
#pragma unroll
        for (int t = 0; t < 2; ++t) { const int dt = sub + t, vt = it; f32x16 kv;
#pragma unroll
            for (int i = 0; i < 16; ++i) kv[i] = 0.f;
#pragma unroll
            for (int s = 0; s < 8; ++s) { const bf16x8 a = tr_frag(lds + EV_K, lane, dt, s), bv = *(const LAS bf16x8*)(lds + EV_VT + offb(32 * vt + r, 2 * s + hh));
                kv = __builtin_amdgcn_mfma_f32_32x32x16_bf16(a, bv, kv, 0, 0, 0); }
#pragma unroll
            for (int q = 0; q < 4; ++q) { u32x2 w2; w2.x = pk2(kv[4 * q], kv[4 * q + 1]); w2.y = pk2(kv[4 * q + 2], kv[4 * q + 3]);
                *(LAS u32x2*)(lds + EV_CT + offb(32 * vt + r, 4 * dt + q) + 8 * hh) = w2; } }
        if (!RET && tid < 128) { float a = 0.f;
#pragma unroll
            for (int w = 0; w < NWAVES; ++w) a += *(const LAS float*)(sc + SC_NP + w * 512 + 4 * tid);
            ((float*)(P.ws() + WS_NC))[(size_t)item * 128 + tid] = a; }
    }
    __syncthreads();
    { unsigned char* dst = (unsigned char*)P.out() + (size_t)item * 32768 + 16 * tid;
#pragma unroll
      for (int k = 0; k < 4; ++k) *(GAS v4u*)(dst + k * 8192) = *(const LAS v4u*)(lds + EV_CT + 16 * tid + k * 8192); }
    __syncthreads();
#undef EV_LD
}
__device__ __forceinline__ void ev_p2_scan(const Ptrs& P, int gtid, int NT) {
    unsigned char* KV = (unsigned char*)P.out(); float* NC = (float*)(P.ws() + WS_NC); const float* SCAL = (const float*)(P.ws() + WS_SCAL); float* MPREV = (float*)(P.ws() + WS_MPREV);
    for (int v = gtid; v < 64 * 2048 + 32 * 128; v += NT) {
        const bool isn = v >= 64 * 2048; const int hi = isn ? (v - 64 * 2048) >> 7 : v >> 11, e = isn ? (v - 64 * 2048) & 127 : v & 2047;
        const bool ret = hi >= 32; const float gam = __expf(128.0f * __logf(1.0f - exp2f(-5.0f - (float)(hi & 3))));
        v4u xs[16]; float xn[16]; f32x2v ms[16];
#pragma unroll
        for (int c = 0; c < 16; ++c) { const int item = hi * 16 + c;
            if (isn) xn[c] = NC[(size_t)item * 128 + e]; else xs[c] = *(const GAS v4u*)(KV + (size_t)item * 32768 + 16 * e);
            ms[c] = ret ? (f32x2v){0.f, 0.f} : *(const GAS f32x2v*)(SCAL + 2 * item); }
        float C[8];
#pragma unroll
        for (int k = 0; k < 8; ++k) C[k] = 0.f;
        float m = -1e30f;
#pragma unroll
        for (int c = 0; c < 16; ++c) { const int item = hi * 16 + c; float so = gam, sn = 1.0f;
            if (!ret) { const float mloc = ms[c].x, tot = ms[c].y; const float mn = fmaxf(tot + m, mloc); so = __expf(tot + m - mn); sn = __expf(mloc - mn);
                if (!isn && e == 0) MPREV[item] = m; m = mn; }
            if (isn) { NC[(size_t)item * 128 + e] = C[0]; C[0] = so * C[0] + sn * xn[c]; }
            else { float x[8]; unpk8(xs[c], x); *(GAS v4u*)(KV + (size_t)item * 32768 + 16 * e) = pk8(C);
#pragma unroll
                for (int k = 0; k < 8; ++k) C[k] = so * C[k] + sn * x[k]; } }
    }
}
template <bool RET>
__device__ __forceinline__ void ev_p3_item(const Ptrs& P, int jl, LAS unsigned char* lds, int item, int tid_in) {
    int tid = tid_in; asm volatile("" : "+v"(tid));
    const bf16* Z = (const bf16*)(P.ws() + WS_Z);
    const int hi = item >> 4, c = item & 15, b = (hi >> 2) & 7, h = hi & 3;
    const int lane = tid & 63, wv = __builtin_amdgcn_readfirstlane(tid >> 6), r = lane & 31, hh = lane >> 5;
    LAS unsigned char* sc = lds + EV_SC; LAS unsigned char* scp = sc;
    constexpr int NRAW = RET ? 4 : 7; constexpr int COL_K = RET ? 2560 : 512, COL_Q = RET ? 2048 : 0, COL_V = RET ? 3072 : 1024, COL_G = RET ? 3584 : 1536;
    const size_t rowbase = (size_t)b * SEQ + (size_t)c * CHUNK; const bf16* zc = Z + rowbase * EV_N;
    const int jg = tid >> 4, dc = tid & 15, j0 = 4 * jg; const unsigned voff = (unsigned)(j0 * EV_N + 8 * dc) * 2u;
    const bf16* zu = zc + h * 128;
#define EV_LD(ub, vo) (*(const GAS v4u*)((const GAS char*)(ub) + (size_t)(unsigned)(vo)))
    G4 gq{0.f, 0.f, 0.f, 0.f, h}; float mp = 0.f, npv = 0.f;
    if constexpr (!RET) {
        if (wv == 0) { const float* gp = (const float*)(P.ws() + WS_GATES) + (rowbase + 2 * lane) * 8; gq.a = gp[h]; gq.b = gp[4 + h]; gq.c = gp[8 + h]; gq.d = gp[12 + h]; mp = ((const float*)(P.ws() + WS_MPREV))[item]; }
        if (wv >= 2 && wv < 4) npv = ((const float*)(P.ws() + WS_NC))[(size_t)item * 128 + (tid - 128)];
    }
    v4u pk[NRAW], pq[NRAW], pv[4], cti[4];
    if constexpr (!RET) {
#pragma unroll
        for (int rr = 0; rr < 7; ++rr) { if (c == 0 && j0 - 3 + rr < 0) { pk[rr] = (v4u){0u, 0u, 0u, 0u}; pq[rr] = (v4u){0u, 0u, 0u, 0u}; } else { pk[rr] = EV_LD(zu + (long)(rr - 3) * EV_N + COL_K, voff); pq[rr] = EV_LD(zu + (long)(rr - 3) * EV_N + COL_Q, voff); } }
    } else {
#pragma unroll
        for (int jj = 0; jj < 4; ++jj) { pk[jj] = EV_LD(zu + (long)jj * EV_N + COL_K, voff); pq[jj] = EV_LD(zu + (long)jj * EV_N + COL_Q, voff); }
    }
#pragma unroll
    for (int jj = 0; jj < 4; ++jj) pv[jj] = EV_LD(zu + (long)jj * EV_N + COL_V, voff);
    { const unsigned char* src = (unsigned char*)P.out() + (size_t)item * 32768 + 16 * tid;
#pragma unroll
      for (int k = 0; k < 4; ++k) cti[k] = *(const GAS v4u*)(src + k * 8192); }
    if (tid < 128) *(LAS float*)(sc + SC_NG + 4 * tid) = (RET ? P.ev_ngr() : P.ev_ngm())[jl * 512 + h * 128 + tid];
    if constexpr (!RET) {
        if (wv == 0) { float mloc, tot; EV_SCALARS(true, gq, mp, lane, sc, mloc, tot); (void)mloc; (void)tot; }
        if (wv >= 2 && wv < 4) *(LAS float*)(sc + SC_N + 4 * (tid - 128)) = npv;
        if (tid >= 256) { const int isq = (tid - 256) >> 7, d = tid & 127, ch = (isq ? 512 : 0) + h * 128 + d; const float* cw = P.ev_cw() + (size_t)jl * 4096;
#pragma unroll
            for (int tap = 0; tap < 4; ++tap) *(LAS float*)(sc + SC_WL + ((isq * 5 + tap) * 128 + d) * 4) = cw[tap * 1024 + ch];
            *(LAS float*)(sc + SC_WL + ((isq * 5 + 4) * 128 + d) * 4) = P.ev_cb()[jl * 1024 + ch]; }
    } else if (tid < 128) { const float lg = __logf(1.0f - exp2f(-5.0f - (float)h));
        *(LAS float*)(sc + SC_G + 4 * tid) = __expf(lg * (float)(127 - tid)); *(LAS float*)(sc + SC_RF + 4 * tid) = __expf(lg * (float)(tid - 127)); *(LAS float*)(sc + SC_INT + 4 * tid) = __expf(lg * (float)(tid + 1)); }
    __syncthreads();
    {
        float o4[4][8]; const f32x4 gj = *(const LAS f32x4*)(scp + SC_G + 16 * jg);
        f32x4 prot[RET ? 16 : 1];
        if constexpr (RET) { const float* rp = (const float*)(P.ws() + WS_ROT) + ((size_t)(c * CHUNK + j0) * 64 + 8 * (dc & 7)) * 2;
#pragma unroll
            for (int jj = 0; jj < 4; ++jj)
#pragma unroll
                for (int e2 = 0; e2 < 4; ++e2) prot[4 * jj + e2] = *(const GAS f32x4*)(rp + jj * 128 + 4 * e2); }
        if constexpr (!RET) conv4_silu_pre(pk, sc + SC_WL + 5 * 128 * 4, dc, o4); else rot4_pre(pk, prot, dc, lane, o4);
#pragma unroll
        for (int jj = 0; jj < 4; ++jj) { const float gs = KSCALE * gj[jj];
#pragma unroll
            for (int e = 0; e < 8; ++e) o4[jj][e] *= gs;
            *(LAS v4u*)(lds + EV_K + offb(j0 + jj, dc)) = pk8(o4[jj]); }
        if constexpr (!RET) conv4_silu_pre(pq, sc + SC_WL, dc, o4); else rot4_pre(pq, prot, dc, lane, o4);
#pragma unroll
        for (int jj = 0; jj < 4; ++jj) *(LAS v4u*)(lds + EV_Q + offb(j0 + jj, dc)) = pk8(o4[jj]);
#pragma unroll
        for (int e = 0; e < 8; ++e) { unsigned short v4[4];
#pragma unroll
            for (int jj = 0; jj < 4; ++jj) v4[jj] = (unsigned short)((e & 1) ? (pv[jj][e >> 1] >> 16) : (pv[jj][e >> 1] & 0xffffu));
            u32x2 w2; w2.x = (unsigned)v4[0] | ((unsigned)v4[1] << 16); w2.y = (unsigned)v4[2] | ((unsigned)v4[3] << 16);
            *(LAS u32x2*)(lds + EV_VT + offb(8 * dc + e, jg >> 1) + 8 * (jg & 1)) = w2; }
#pragma unroll
        for (int k = 0; k < 4; ++k) *(LAS v4u*)(lds + EV_CT + 16 * tid + k * 8192) = cti[k];
    }
    __syncthreads();
    const int it = wv >> 1, sub = (wv & 1) * 2;
    f32x16 Pt[2], Ot[2];
    {
        const float rfi = *(const LAS float*)(scp + SC_RF + 4 * (32 * it + r));
#pragma unroll
        for (int t = 0; t < 2; ++t) { const int jt = sub + t;
#pragma unroll
            for (int i = 0; i < 16; ++i) Pt[t][i] = 0.f;
            if (jt <= it) {
#pragma unroll
                for (int s = 0; s < 8; ++s) { const bf16x8 a = *(const LAS bf16x8*)(lds + EV_K + offb(32 * jt + r, 2 * s + hh)), bq = *(const LAS bf16x8*)(lds + EV_Q + offb(32 * it + r, 2 * s + hh));
                    Pt[t] = __builtin_amdgcn_mfma_f32_32x32x16_bf16(a, bq, Pt[t], 0, 0, 0); }
#pragma unroll
                for (int i = 0; i < 16; ++i) { float v = Pt[t][i] * rfi; if (jt == it && crow(i, hh) > r) v = 0.f; Pt[t][i] = v; }
            } }
    }
    if constexpr (!RET) {
        const int i = tid >> 2, part = tid & 3; float a = 0.f;
#pragma unroll
        for (int cc = 0; cc < 4; ++cc) { float q8[8]; unpk8(*(const LAS v4u*)(lds + EV_Q + offb(i, 4 * part + cc)), q8);
            const f32x4 n0 = *(const LAS f32x4*)(sc + SC_N + 4 * (32 * part + 8 * cc)), n1 = *(const LAS f32x4*)(sc + SC_N + 4 * (32 * part + 8 * cc + 4));
            a += q8[0] * n0.x + q8[1] * n0.y + q8[2] * n0.z + q8[3] * n0.w + q8[4] * n1.x + q8[5] * n1.y + q8[6] * n1.z + q8[7] * n1.w; }
        a += sx<1>(a, lane); a += sx<2>(a, lane);
        if (part == 0) *(LAS float*)(sc + SC_QN + 4 * i) = a;
    }
    {
        const float inter = *(const LAS float*)(scp + SC_INT + 4 * (32 * it + r));
#pragma unroll
        for (int t = 0; t < 2; ++t) { const int vt2 = sub + t; f32x16 o;
#pragma unroll
            for (int i = 0; i < 16; ++i) o[i] = 0.f;
#pragma unroll
            for (int s = 0; s < 8; ++s) { const bf16x8 a = *(const LAS bf16x8*)(lds + EV_CT + offb(32 * vt2 + r, 2 * s + hh)), bq = *(const LAS bf16x8*)(lds + EV_Q + offb(32 * it + r, 2 * s + hh));
                o = __builtin_amdgcn_mfma_f32_32x32x16_bf16(a, bq, o, 0, 0, 0); }
#pragma unroll
            for (int i = 0; i < 16; ++i) Ot[t][i] = o[i] * inter; }
    }
    __syncthreads();
#pragma unroll
    for (int t = 0; t < 2; ++t) { const int jt = sub + t;
        if (jt <= it) {
#pragma unroll
            for (int q = 0; q < 4; ++q) { u32x2 w2; w2.x = pk2(Pt[t][4 * q], Pt[t][4 * q + 1]); w2.y = pk2(Pt[t][4 * q + 2], Pt[t][4 * q + 3]);
                *(LAS u32x2*)(lds + EV_K + offb(32 * it + r, 4 * jt + q) + 8 * hh) = w2; } } }
    __syncthreads();
    const int ei = tid >> 2, epart = tid & 3;
    const bf16* zrow = zc + (size_t)ei * EV_N + COL_G + h * 128 + 32 * epart;
    v4u og[4];
#pragma unroll
    for (int cc = 0; cc < 4; ++cc) og[cc] = *(const GAS v4u*)(zrow + 8 * cc);
#pragma unroll
    for (int t = 0; t < 2; ++t) { const int vt2 = sub + t;
        for (int s = 0; s < 2 * (it + 1); ++s) { const bf16x8 a = *(const LAS bf16x8*)(lds + EV_VT + offb(32 * vt2 + r, 2 * s + hh)), bp = *(const LAS bf16x8*)(lds + EV_K + offb(32 * it + r, 2 * s + hh));
            Ot[t] = __builtin_amdgcn_mfma_f32_32x32x16_bf16(a, bp, Ot[t], 0, 0, 0); }
#pragma unroll
        for (int q = 0; q < 4; ++q) { u32x2 w2; w2.x = pk2(Ot[t][4 * q], Ot[t][4 * q + 1]); w2.y = pk2(Ot[t][4 * q + 2], Ot[t][4 * q + 3]);
            *(LAS u32x2*)(lds + EV_Q + offb(32 * it + r, 4 * vt2 + q) + 8 * hh) = w2; } }
    __syncthreads();
    {
        float gate[32];
#pragma unroll
        for (int cc = 0; cc < 4; ++cc) { float o8[8]; unpk8(og[cc], o8);
#pragma unroll
            for (int e = 0; e < 8; ++e) gate[8 * cc + e] = RET ? siluf_(o8[e]) : sigmoidf_(o8[e]); }
        const int i = ei, part = epart; float x[32];
#pragma unroll
        for (int cc = 0; cc < 4; ++cc) { float t8[8]; unpk8(*(const LAS v4u*)(lds + EV_Q + offb(i, 4 * part + cc)), t8);
#pragma unroll
            for (int e = 0; e < 8; ++e) x[8 * cc + e] = t8[e]; }
        if constexpr (!RET) {
            float ps = 0.f;
#pragma unroll
            for (int cc = 0; cc < 4; ++cc) { float t8[8]; unpk8(*(const LAS v4u*)(lds + EV_K + offb(i, 4 * part + cc)), t8);
                ps += ((t8[0] + t8[1]) + (t8[2] + t8[3])) + ((t8[4] + t8[5]) + (t8[6] + t8[7])); }
            ps = part <= (i >> 5) ? ps : 0.f;
            ps += sx<1>(ps, lane); ps += sx<2>(ps, lane);
            const float den = ps + *(const LAS float*)(scp + SC_INT + 4 * i) * *(const LAS float*)(sc + SC_QN + 4 * i);
            const float inv = __builtin_amdgcn_rcpf(fmaxf(fabsf(den), *(const LAS float*)(scp + SC_EMM + 4 * i)));
#pragma unroll
            for (int k = 0; k < 32; ++k) x[k] *= inv * gate[k];
        }
        float s = 0.f;
#pragma unroll
        for (int k = 0; k < 32; ++k) s += x[k];
        s += sx<1>(s, lane); s += sx<2>(s, lane);
        const float mean = s * (1.0f / 128.0f); float q = 0.f;
#pragma unroll
        for (int k = 0; k < 32; ++k) { x[k] -= mean; q += x[k] * x[k]; }
        q += sx<1>(q, lane); q += sx<2>(q, lane);
        const float rstd = __builtin_amdgcn_rsqf(q * (1.0f / 128.0f) + EPS);
        bf16* mo = (bf16*)(P.ws() + WS_MIXED) + (rowbase + i) * D + (RET ? 512 : 0) + h * 128 + 32 * part;
#pragma unroll
        for (int cc = 0; cc < 4; ++cc) { const f32x4 g0 = *(const LAS f32x4*)(sc + SC_NG + 4 * (32 * part + 8 * cc)), g1 = *(const LAS f32x4*)(sc + SC_NG + 4 * (32 * part + 8 * cc + 4)); float y[8];
            y[0] = x[8 * cc] * rstd * g0.x; y[1] = x[8 * cc + 1] * rstd * g0.y; y[2] = x[8 * cc + 2] * rstd * g0.z; y[3] = x[8 * cc + 3] * rstd * g0.w;
            y[4] = x[8 * cc + 4] * rstd * g1.x; y[5] = x[8 * cc + 5] * rstd * g1.y; y[6] = x[8 * cc + 6] * rstd * g1.z; y[7] = x[8 * cc + 7] * rstd * g1.w;
            if constexpr (RET) {
#pragma unroll
                for (int e = 0; e < 8; ++e) y[e] *= gate[8 * cc + e]; }
            *(GAS v4u*)(mo + 8 * cc) = pk8(y); }
    }
    __syncthreads();
#undef EV_LD
}

struct Args { const float* in[23]; float* out; unsigned char* ws; int ph_lo, ph_hi; };
constexpr int N_PHASES = 2 + 7 * ((DEPTH + 1) / 2) + 5 * (DEPTH / 2);
#ifndef RPT_P1
#define RPT_P1 1
#endif
#ifndef RPT_P3
#define RPT_P3 1
#endif
#ifndef RPT_M
#define RPT_M 1
#endif
#ifndef RPT_R
#define RPT_R 1
#endif
#ifndef RPT_CV
#define RPT_CV 1
#endif
#ifndef RPT_WIN
#define RPT_WIN 1
#endif
#ifndef RPT_MIX
#define RPT_MIX 1
#endif
#ifndef RPT_GU
#define RPT_GU 1
#endif
#ifndef MK_ONE_LAUNCH
#define MK_ONE_LAUNCH 1
#endif
__global__ void __launch_bounds__(NWAVES * 64, 2) mk_fwd(Args args) {
    extern __shared__ __attribute__((aligned(16))) unsigned char lds_raw[];
    LAS unsigned char* lds = (LAS unsigned char*)lds_raw;
    volatile LAS unsigned* MISC = (volatile LAS unsigned*)(lds + MISC_OFF);
    const int wave_s = __builtin_amdgcn_readfirstlane((int)threadIdx.x >> 6);
#define HWTID() (wave_s * 64 + hw_lane())
    const int G = gridDim.x, bx = blockIdx.x;
    const int vcu = (G % 8 == 0) ? (bx % 8) * (G / 8) + bx / 8 : bx;
    const int NGW = G * NWAVES;
#define GW (vcu * NWAVES + wave)
    const Ptrs P;
    gu32* ctl = (gu32*)(P.ws() + WS_CTL);
    for (int u = HWTID(); u < (LDS_BYTES - LDSCTL_OFF) / 4; u += NWAVES * 64) ((LAS unsigned*)(lds + LDSCTL_OFF))[u] = 0u;
    __syncthreads();
    const int lo = P.ph_lo(), hi = P.ph_hi();
    const bool use_bar = (hi - lo) > 1;
    XcdBarrier bar; bar.bar = (unsigned*)(ctl + CW_BAR); bar.x = 0; bar.st = nullptr;
    if (use_bar) bar = xcd_barrier_post((unsigned*)(ctl + CW_BAR), MISC + 8, HWTID());
#define IN(k) (lo <= (k) && (k) < hi)
#define FRESH() int tid = HWTID(); asm volatile("" : "+v"(tid)); const int lane = tid & 63, wave = __builtin_amdgcn_readfirstlane(tid >> 6); (void)lane; (void)wave
#define TAIL_CV(nwg_, body_) do { const int rem_ = (nwg_) % G; if (rem_ == 0 || bx >= rem_) { FRESH(); const int wk = (rem_ ? bx - rem_ : bx) * NWAVES + wave, NWK = (rem_ ? G - rem_ : G) * NWAVES; \
        LAS float* scr = (LAS float*)(lds + RING_OFF + wave * 16384); (void)lane; body_; } } while (0)
#define SEAM(k) do { if (IN(k) && IN((k) + 1)) xcd_barrier(bar, HWTID()); } while (0)

#define XB ((bf16*)(P.ws() + WS_XB))
#define MIXED ((bf16*)(P.ws() + WS_MIXED))
#define ZB ((bf16*)(P.ws() + WS_Z))
#define ACT ((bf16*)(P.ws() + WS_Z))
#define SSQ ((float*)(P.ws() + WS_SSQ))
    if (IN(0)) { FRESH(); LAS float* scr = (LAS float*)(lds + RING_OFF + wave * 16384); prologue_rows(P, GW, NGW, lane); cv_in(P, 0, scr, GW, NGW, lane); cv_out(P, 0, scr, GW, NGW, lane); }
    SEAM(0);
    int pbase = 0;
    for (int L = 0; L < DEPTH; ++L) {
        const int j = L >> 1; const bool even = (L & 1) == 0;
        const int p_in = pbase + 1, p_mix = pbase + 2, p_out = pbase + (even ? 5 : 3), p_gu = p_out + 1, p_dn = p_out + 2; pbase = p_dn;
        if (IN(p_in)) for (int rp = 0; rp < RPT_WIN; ++rp) {
            if (rp) xcd_barrier(bar, HWTID());
            const int N = even ? EV_N : OD_N;
            pg8::Gemm g{XB, (const bf16*)(P.ws() + (even ? WS_WIN_A : WS_WIN_B)), M, N, D}; pg8::StaticOrder S; S.init(M, N, G, bx);
            pg8::EpiZ E{ZB, N, SSQ};
            pg8::gemm_phase<pg8::EpiZ, pg8::StaticOrder, true, true>(lds + RING_OFF, g, S, E, HWTID());
            if (even) { FRESH(); gates_rows(P, j, GW, NGW, lane); }
            else if (L == 1) { TAIL_CV((M / 256) * (OD_N / 256), cv_ffn(P, 2, scr, wk, NWK, lane)); }
        }
        SEAM(p_in);
        if (even) {
            if (IN(p_mix)) for (int rp = 0; rp < RPT_P1; ++rp) { if (rp) xcd_barrier(bar, HWTID()); FRESH();
                for (int it = bx; it < 1024; it += G) { if ((it >> 4) >= 32) ev_p1_item<true>(P, j, lds, it, tid); else ev_p1_item<false>(P, j, lds, it, tid); }
                LAS float* scr = (LAS float*)(lds + RING_OFF + wave * 16384);
                if (L == 0) cv_ffn(P, 0, scr, GW, NGW, lane); }
            SEAM(p_mix);
            if (IN(p_mix + 1)) { FRESH(); ev_p2_scan(P, (bx * NWAVES + wave) * 64 + lane, G * NWAVES * 64); }
            SEAM(p_mix + 1);
            if (IN(p_mix + 2)) for (int rp = 0; rp < RPT_P3; ++rp) { if (rp) xcd_barrier(bar, HWTID()); FRESH();
                for (int it = bx; it < 1024; it += G) { if ((it >> 4) >= 32) ev_p3_item<true>(P, j, lds, it, tid); else ev_p3_item<false>(P, j, lds, it, tid); } }
            SEAM(p_mix + 2);
        } else {
            if (IN(p_mix)) { FRESH(); for (int it = bx; it < M / 64; it += G) od_fast_item(P, j, lds, it, tid); }
            SEAM(p_mix);
        }
        if (IN(p_out)) {
            pg8::Gemm g{MIXED, (const bf16*)(P.ws() + WS_WOUT) + (size_t)L * D * D, M, D, D}; pg8::StaticOrder S; S.init(M, D, G, bx);
            pg8::EpiRes E{XB, SSQ, D};
            pg8::gemm_phase<pg8::EpiRes, pg8::StaticOrder, true, true>(lds + RING_OFF, g, S, E, HWTID());
        }
        SEAM(p_out);
        if (IN(p_gu)) for (int rp = 0; rp < RPT_GU; ++rp) {
            if (rp) xcd_barrier(bar, HWTID());
            pg8::Gemm g{XB, (const bf16*)(P.ws() + (even ? WS_WGU_A : WS_WGU_B)), M, NGU, D}; pg8::StaticOrder S; S.init(M, NGU, G, bx);
            pg8::EpiSwiGLU E{ACT, DFF, SSQ};
            pg8::gemm_phase<pg8::EpiSwiGLU, pg8::StaticOrder, true, true>(lds + RING_OFF, g, S, E, HWTID());
            if (L == 0) { TAIL_CV((M / 256) * (NGU / 256), (cv_in(P, 1, scr, wk, NWK, lane), cv_out(P, 1, scr, wk, NWK, lane), cv_ffn(P, 1, scr, wk, NWK, lane))); }
            else if (L == 1) { TAIL_CV((M / 256) * (NGU / 256), (cv_in(P, 2, scr, wk, NWK, lane), cv_out(P, 2, scr, wk, NWK, lane), cv_in(P, 3, scr, wk, NWK, lane), cv_out(P, 3, scr, wk, NWK, lane))); }
            else if (L == 2) { TAIL_CV((M / 256) * (NGU / 256), cv_ffn(P, 3, scr, wk, NWK, lane)); }
        }
        SEAM(p_gu);
        if (IN(p_dn)) {
            pg8::Gemm g{ACT, (const bf16*)(P.ws() + (even ? WS_WD_A : WS_WD_B)), M, D, DFF}; pg8::StaticOrder S; S.init(M, D, G, bx);
            pg8::EpiRes E{XB, SSQ, D};
            pg8::gemm_phase<pg8::EpiRes, pg8::StaticOrder, true, true>(lds + RING_OFF, g, S, E, HWTID());
        }
        SEAM(p_dn);
    }
    if (IN(N_PHASES - 1)) { FRESH(); final_norm(P, GW, NGW, lane); }
#undef IN
#undef SEAM
#undef TAIL_CV
#undef FRESH
#undef HWTID
#undef GW
#undef XB
#undef MIXED
#undef ZB
#undef ACT
#undef SSQ
}

extern "C" void kernel_launch(void* const* d_in, const int* in_sizes, int n_in, void* d_out, int out_size, void* d_ws, size_t ws_size, hipStream_t stream) {
    static int grid = 0;
    if (grid == 0) {
        if (n_in != 23 || in_sizes[0] != M * D || out_size != M * D || ws_size < WS_END) { fprintf(stderr, "kernel_launch: unexpected shapes (n_in %d, in0 %d, out %d, ws %zu)\n", n_in, n_in > 0 ? in_sizes[0] : -1, out_size, ws_size); grid = -1; return; }
        int dev = 0, cus = 0, per_cu = 0;
        if (hipGetDevice(&dev) != hipSuccess || hipDeviceGetAttribute(&cus, hipDeviceAttributeMultiprocessorCount, dev) != hipSuccess) { grid = -1; return; }
        if (hipFuncSetAttribute((const void*)mk_fwd, hipFuncAttributeMaxDynamicSharedMemorySize, LDS_BYTES) != hipSuccess) { fprintf(stderr, "kernel_launch: hipFuncSetAttribute failed\n"); grid = -1; return; }
        if (hipOccupancyMaxActiveBlocksPerMultiprocessor(&per_cu, (const void*)mk_fwd, NWAVES * 64, LDS_BYTES) != hipSuccess || per_cu < 1) { fprintf(stderr, "kernel_launch: occupancy query reports %d blocks per CU\n", per_cu); per_cu = 1; }
        (void)hipGetLastError();
        grid = cus;
        if (grid > 256) grid = 256;
    }
    if (grid < 0) return;
    (void)hipMemsetAsync((char*)d_ws + WS_CTL, 0, CTL_ZERO_BYTES, stream);
    Args a{};
    for (int i = 0; i < 23; ++i) a.in[i] = (const float*)d_in[i];
    a.out = (float*)d_out; a.ws = (unsigned char*)d_ws;
#if MK_ONE_LAUNCH
    a.ph_lo = 0; a.ph_hi = N_PHASES;
    hipLaunchKernelGGL(mk_fwd, dim3(grid), dim3(NWAVES * 64), LDS_BYTES, stream, a);
#else
    for (int ph = 0; ph < N_PHASES; ++ph) { a.ph_lo = ph; a.ph_hi = ph + 1; hipLaunchKernelGGL(mk_fwd, dim3(grid), dim3(NWAVES * 64), LDS_BYTES, stream, a); }
#endif
}
```

```cpp
#include <hip/hip_runtime.h>
#include <cstdio>
#include <cstdint>
#include <cmath>

template <int MASK> __device__ __forceinline__ float sx(float v, int lane) {
    if constexpr (MASK < 32) return __builtin_bit_cast(float, __builtin_amdgcn_ds_swizzle(__builtin_bit_cast(int, v), (MASK << 10) | 0x1f));
    else return __builtin_bit_cast(float, __builtin_amdgcn_ds_bpermute((lane ^ 32) << 2, __builtin_bit_cast(int, v)));
}
template <int MASK> __device__ __forceinline__ unsigned sxu(unsigned v, int lane) {
    if constexpr (MASK < 32) return (unsigned)__builtin_amdgcn_ds_swizzle((int)v, (MASK << 10) | 0x1f);
    else return (unsigned)__builtin_amdgcn_ds_bpermute((lane ^ 32) << 2, (int)v);
}
__device__ __forceinline__ float shup(float v, int o, int lane) { return __builtin_bit_cast(float, __builtin_amdgcn_ds_bpermute((lane - o) << 2, __builtin_bit_cast(int, v))); }
namespace pg8 {
#define PG8_LAS __attribute__((address_space(3)))
typedef unsigned short bf16_t;
typedef short bf16x8 __attribute__((ext_vector_type(8)));
typedef float f32x4 __attribute__((ext_vector_type(4)));
typedef unsigned u32x4 __attribute__((ext_vector_type(4)));
constexpr int BM = 256, BK = 64, HALF = 128, HTB = HALF * BK * 2  , STAGE_BYTES = 8 * HTB, NXCD = 8, WGM = 8;

__host__ __device__ __forceinline__ int lds_byte(int r, int c) { const int st = (r >> 4) * 2 + (c >> 5), rr = r & 15, cc = c & 31, ob = rr * 64 + cc * 2; return st * 1024 + (ob ^ (((ob >> 9) & 1) << 5)); }
__host__ __device__ __forceinline__ void stage_rc(int b, int& R, int& C) { const int st = b / 1024, sb = b % 1024, swz = sb ^ (((sb >> 9) & 1) << 5); R = (st >> 1) * 16 + swz / 64; C = (st & 1) * 32 + (swz % 64) / 2; }
__host__ __device__ __forceinline__ int perm32(int rho) { const int n = rho >> 4, i = rho & 15; return 8 * (i >> 2) + 4 * n + (i & 3); }

struct Unit { int pm, pn; };
struct Gemm { const bf16_t* A; const bf16_t* Bt; int M, N, K; };

struct StaticOrder {
    int nM, nN, nwg, G, c;
    __host__ __device__ void init(int M, int N, int G_, int c_) { nM = M / BM; nN = N / BM; nwg = nM * nN; G = G_; c = c_; }
    __host__ __device__ bool next(int i, Unit& u) const {
        const long L = (long)i * G + c; if (L >= nwg) return false;
        int wgid = (int)L; { const int q = nwg / NXCD, r = nwg % NXCD, xcd = wgid % NXCD, off = wgid / NXCD; wgid = (xcd < r ? xcd * (q + 1) : r * (q + 1) + (xcd - r) * q) + off; }
        const int nig = WGM * nN, gid = wgid / nig, fm = gid * WGM, gsz = (nM - fm) < WGM ? (nM - fm) : WGM;
        u.pm = fm + ((wgid % nig) % gsz); u.pn = (wgid % nig) / gsz; return true;
    }
    __device__ __forceinline__ void a_ready(const Unit&) const {}
    __device__ __forceinline__ void done(const Unit&) const {}
};


__device__ __forceinline__ unsigned cvt_pk_bf16(float lo, float hi) { unsigned r; asm volatile("v_cvt_pk_bf16_f32 %0, %1, %2" : "=v"(r) : "v"(lo), "v"(hi)); return r; }
typedef float f32x2 __attribute__((ext_vector_type(2)));

typedef float f32x2 __attribute__((ext_vector_type(2)));
typedef unsigned u32x2 __attribute__((ext_vector_type(2)));
typedef int i32x4 __attribute__((ext_vector_type(4)));
constexpr float RMS_EPS = 1e-6f;
__device__ __forceinline__ float row_rstd(const float* ssq, int row, int fq, int lane) {
    const f32x4 p = *(const f32x4*)(ssq + (size_t)row * 16 + 4 * fq);
    float s = (p[0] + p[1]) + (p[2] + p[3]);
    s += sx<16>(s, lane); s += sx<32>(s, lane);
    return __builtin_amdgcn_rsqf(s * (1.0f / 1024.0f) + RMS_EPS);
}
__device__ __forceinline__ void row_rstd8(const float* ssq, int row0, int fq, int lane, float (&rs)[2][4]) {
    f32x4 p[2][4];
#pragma unroll
    for (int ai = 0; ai < 2; ++ai)
#pragma unroll
        for (int m = 0; m < 4; ++m) p[ai][m] = *(const f32x4*)(ssq + (size_t)(row0 + ai * HALF + m * 16) * 16 + 4 * fq);
    asm volatile("" : "+v"(p[0][0]), "+v"(p[0][1]), "+v"(p[0][2]), "+v"(p[0][3]), "+v"(p[1][0]), "+v"(p[1][1]), "+v"(p[1][2]), "+v"(p[1][3]));
#pragma unroll
    for (int ai = 0; ai < 2; ++ai)
#pragma unroll
        for (int m = 0; m < 4; ++m) { float s = (p[ai][m][0] + p[ai][m][1]) + (p[ai][m][2] + p[ai][m][3]); s += sx<16>(s, lane); s += sx<32>(s, lane); rs[ai][m] = __builtin_amdgcn_rsqf(s * (1.0f / 1024.0f) + RMS_EPS); }
}
struct EpiZ {
    static constexpr bool PERM = true, AFTER_DRAIN = false;
    bf16_t* O; int ldc; const float* ssq;
    __device__ __forceinline__ void operator()(const f32x4 (&acc)[2][2][4][2], const Unit& u, int wr, int wc, int fr, int fq) const {
        const int row0 = u.pm * BM + wr * 64 + fr, col0 = u.pn * BM + wc * 32 + 8 * fq;
        float rsv[2][4]; row_rstd8(ssq, row0, fq, fq * 16 + fr, rsv);
#pragma unroll
        for (int ai = 0; ai < 2; ++ai)
#pragma unroll
            for (int m = 0; m < 4; ++m) { const int row = row0 + ai * HALF + m * 16; const float rs = rsv[ai][m];
                bf16_t* rowp = O + (size_t)row * ldc + col0;
#pragma unroll
                for (int bj = 0; bj < 2; ++bj) { const f32x4 v0 = acc[ai][bj][m][0] * rs, v1 = acc[ai][bj][m][1] * rs;
                    u32x4 w; w.x = cvt_pk_bf16(v0[0], v0[1]); w.y = cvt_pk_bf16(v0[2], v0[3]); w.z = cvt_pk_bf16(v1[0], v1[1]); w.w = cvt_pk_bf16(v1[2], v1[3]);
                    *(u32x4*)(rowp + bj * HALF) = w; } }
    }
};
struct EpiSwiGLU {
    static constexpr bool PERM = true, AFTER_DRAIN = false;
    bf16_t* O; int ldc; const float* ssq;
    __device__ __forceinline__ void operator()(const f32x4 (&acc)[2][2][4][2], const Unit& u, int wr, int wc, int fr, int fq) const {
        const int row0 = u.pm * BM + wr * 64 + fr, col0 = u.pn * HALF + wc * 32 + 8 * fq;
        float rsv[2][4]; row_rstd8(ssq, row0, fq, fq * 16 + fr, rsv);
#pragma unroll
        for (int ai = 0; ai < 2; ++ai)
#pragma unroll
            for (int m = 0; m < 4; ++m) { const int row = row0 + ai * HALF + m * 16; const float rs = rsv[ai][m];
                float o[8];
#pragma unroll
                for (int n = 0; n < 2; ++n)
#pragma unroll
                    for (int e = 0; e < 4; ++e) { const float g = acc[ai][0][m][n][e] * rs, up = acc[ai][1][m][n][e] * rs;
                        const float sg = g * __builtin_amdgcn_rcpf(1.0f + __builtin_amdgcn_exp2f(-1.4426950408889634f * g)); o[4 * n + e] = sg * up; }
                u32x4 w; w.x = cvt_pk_bf16(o[0], o[1]); w.y = cvt_pk_bf16(o[2], o[3]); w.z = cvt_pk_bf16(o[4], o[5]); w.w = cvt_pk_bf16(o[6], o[7]);
                *(u32x4*)(O + (size_t)row * ldc + col0) = w; }
    }
};
struct EpiSwiGLUq {
    static constexpr bool PERM = true, AFTER_DRAIN = false;
    bf16_t* O; int ldc; const float* rsq; const float* cs;
    __device__ __forceinline__ void operator()(const f32x4 (&acc)[2][2][4][2], const Unit& u, int wr, int wc, int fr, int fq) const {
        const int row0 = u.pm * BM + wr * 64 + fr, col0 = u.pn * HALF + wc * 32 + 8 * fq, sc0 = u.pn * BM + wc * 32 + 8 * fq;
        float rsv[2][4];
#pragma unroll
        for (int ai = 0; ai < 2; ++ai)
#pragma unroll
            for (int m = 0; m < 4; ++m) rsv[ai][m] = rsq[row0 + ai * HALF + m * 16];
        f32x4 sg[2], su[2];
#pragma unroll
        for (int n = 0; n < 2; ++n) { sg[n] = *(const f32x4*)(cs + sc0 + 4 * n); su[n] = *(const f32x4*)(cs + sc0 + HALF + 4 * n); }
#pragma unroll
        for (int ai = 0; ai < 2; ++ai)
#pragma unroll
            for (int m = 0; m < 4; ++m) { const int row = row0 + ai * HALF + m * 16; const float rs = rsv[ai][m];
                float o[8];
#pragma unroll
                for (int n = 0; n < 2; ++n) { const i32x4 ig = __builtin_bit_cast(i32x4, acc[ai][0][m][n]), iu = __builtin_bit_cast(i32x4, acc[ai][1][m][n]);
#pragma unroll
                    for (int e = 0; e < 4; ++e) { const float g = (float)ig[e] * (rs * sg[n][e]), up = (float)iu[e] * (rs * su[n][e]);
                        const float sgm = g * __builtin_amdgcn_rcpf(1.0f + __builtin_amdgcn_exp2f(-1.4426950408889634f * g)); o[4 * n + e] = sgm * up; } }
                u32x4 w; w.x = cvt_pk_bf16(o[0], o[1]); w.y = cvt_pk_bf16(o[2], o[3]); w.z = cvt_pk_bf16(o[4], o[5]); w.w = cvt_pk_bf16(o[6], o[7]);
                *(u32x4*)(O + (size_t)row * ldc + col0) = w; }
    }
};
struct EpiRes {
    static constexpr bool PERM = false, AFTER_DRAIN = false;
    bf16_t* xb; float* ssq; int ldc;
    __device__ __forceinline__ void operator()(const f32x4 (&acc)[2][2][4][2], const Unit& u, int wr, int wc, int fr, int fq) const {
        const int row0 = u.pm * BM + wr * 64 + fr, col0 = u.pn * BM + wc * 32 + 4 * fq;
#pragma unroll
        for (int ai = 0; ai < 2; ++ai)
#pragma unroll
            for (int m = 0; m < 4; ++m) { const int row = row0 + ai * HALF + m * 16; const size_t off = (size_t)row * ldc + col0; float q = 0.f;
#pragma unroll
                for (int bj = 0; bj < 2; ++bj)
#pragma unroll
                    for (int n = 0; n < 2; ++n) { const size_t o2 = off + bj * HALF + n * 16; const u32x2 xo = *(const u32x2*)(xb + o2);
                        f32x4 xn; xn[0] = __builtin_bit_cast(float, xo.x << 16); xn[1] = __builtin_bit_cast(float, xo.x & 0xffff0000u); xn[2] = __builtin_bit_cast(float, xo.y << 16); xn[3] = __builtin_bit_cast(float, xo.y & 0xffff0000u);
                        xn += acc[ai][bj][m][n];
                        u32x2 w; w.x = cvt_pk_bf16(xn[0], xn[1]); w.y = cvt_pk_bf16(xn[2], xn[3]); *(u32x2*)(xb + o2) = w;
                        q += (xn[0] * xn[0] + xn[1] * xn[1]) + (xn[2] * xn[2] + xn[3] * xn[3]); }
                q += sx<16>(q, fq * 16 + fr); q += sx<32>(q, fq * 16 + fr);
                if (fq == 0) ssq[(size_t)row * 16 + u.pn * 4 + wc] = q;
                asm volatile("" ::: "memory"); }
    }
};


template <bool I8> __device__ __forceinline__ f32x4 mma16(bf16x8 b, bf16x8 a, f32x4 c) {
    if constexpr (I8) return __builtin_bit_cast(f32x4, __builtin_amdgcn_mfma_i32_16x16x64_i8(__builtin_bit_cast(i32x4, b), __builtin_bit_cast(i32x4, a), __builtin_bit_cast(i32x4, c), 0, 0, 0));
    else return __builtin_amdgcn_mfma_f32_16x16x32_bf16(b, a, c, 0, 0, 0);
}
template <class Epi, class Sched, bool ALIGN_EPI = false, bool SP2 = false, bool I8 = false>
__device__ __forceinline__ void gemm_phase(PG8_LAS unsigned char* lds, const Gemm g, const Sched& S, const Epi& E, int tid_in) {
    int tid_ = tid_in; asm volatile("" : "+v"(tid_));
    const int tid = tid_, wid = __builtin_amdgcn_readfirstlane(tid >> 6), lane = tid & 63, wr = wid >> 2, wc = wid & 3, fr = lane & 15, fq = lane >> 4;
    const int K = g.K, nt = K / BK;
    unsigned voffA[2], voffB[2];
#pragma unroll
    for (int i = 0; i < 2; ++i) { int R, C; stage_rc(tid * 16 + i * 8192, R, C); const int Rb = Epi::PERM ? ((R & ~31) + perm32(R & 31)) : R;
        voffA[i] = (unsigned)(R * K + C) * 2u; voffB[i] = (unsigned)(Rb * K + C) * 2u; }
    const size_t kstep = (size_t)(BK * 2);
    const size_t hstep = (size_t)HALF * K * 2;
    const size_t tstep = 2 * hstep;
    const unsigned ldsw = (unsigned)wid * 1024u;
    const int aoff = lds_byte(wr * 64 + fr, fq * 8), boff = lds_byte(wc * 32 + fr, fq * 8);
#define PG8_SA(b, h) (((b) * 2 + (h)) * HTB)
#define PG8_SB(b, h) ((4 + (b) * 2 + (h)) * HTB)
#define PG8_STAGE(bufoff, gbase, voff) do { _Pragma("unroll") for (int _i = 0; _i < 2; ++_i) \
        __builtin_amdgcn_global_load_lds((const unsigned*)((const char*)(gbase) + (voff)[_i]), (PG8_LAS unsigned*)(lds + (bufoff) + ldsw + _i * 8192), 16, 0, 0); } while (0)
#define PG8_LDA(dst, b, h) do { _Pragma("unroll") for (int m = 0; m < 4; ++m) _Pragma("unroll") for (int k = 0; k < 2; ++k) dst[m][k] = *(const PG8_LAS bf16x8*)(lds + PG8_SA(b, h) + aoff + m * 2048 + k * 1024); } while (0)
#define PG8_LDB(dst, b, h) do { _Pragma("unroll") for (int n = 0; n < 2; ++n) _Pragma("unroll") for (int k = 0; k < 2; ++k) dst[n][k] = *(const PG8_LAS bf16x8*)(lds + PG8_SB(b, h) + boff + n * 2048 + k * 1024); } while (0)
#define PG8_MMA(ai, bj, At, Bt) do { __builtin_amdgcn_s_setprio(1); _Pragma("unroll") for (int m = 0; m < 4; ++m) _Pragma("unroll") for (int n = 0; n < 2; ++n) _Pragma("unroll") for (int k = 0; k < 2; ++k) \
        acc[ai][bj][m][n] = mma16<I8>(Bt[n][k], At[m][k], acc[ai][bj][m][n]); __builtin_amdgcn_s_setprio(0); } while (0)
#define PG8_WAIT_V(n) asm volatile("s_waitcnt vmcnt(" #n ")" ::: "memory")
#define PG8_WAIT_L(n) asm volatile("s_waitcnt lgkmcnt(" #n ")" ::: "memory")
#define PG8_BAR __builtin_amdgcn_s_barrier()
#define PG8_SCHED __builtin_amdgcn_sched_barrier(0)
    Unit cur, nxt; int ui = 0;
    if (!S.next(0, cur)) return;
    f32x4 acc[2][2][4][2];
#pragma unroll
    for (int a = 0; a < 2; ++a)
#pragma unroll
        for (int b = 0; b < 2; ++b)
#pragma unroll
            for (int m = 0; m < 4; ++m)
#pragma unroll
                for (int n = 0; n < 2; ++n) acc[a][b][m][n] = (f32x4){0.f, 0.f, 0.f, 0.f};
    bf16x8 At[4][2], B0[2][2], B1[2][2];
    const char* cA = (const char*)g.A + (size_t)cur.pm * tstep; const char* cB = (const char*)g.Bt + (size_t)cur.pn * tstep;
    S.a_ready(cur);
    if constexpr (SP2) {
        PG8_STAGE(PG8_SB(0, 0), cB, voffB); PG8_STAGE(PG8_SB(0, 1), cB + hstep, voffB); PG8_STAGE(PG8_SA(0, 0), cA, voffA); PG8_STAGE(PG8_SA(0, 1), cA + hstep, voffA);
        if (wr == 1) PG8_BAR;
        PG8_WAIT_V(2); PG8_BAR;
        PG8_STAGE(PG8_SB(1, 0), cB + kstep, voffB); PG8_STAGE(PG8_SA(1, 0), cA + kstep, voffA); PG8_STAGE(PG8_SB(1, 1), cB + hstep + kstep, voffB);
        PG8_WAIT_V(6); PG8_BAR;
    } else {
        PG8_STAGE(PG8_SB(0, 0), cB, voffB); PG8_STAGE(PG8_SA(0, 0), cA, voffA); PG8_STAGE(PG8_SB(0, 1), cB + hstep, voffB); PG8_STAGE(PG8_SA(0, 1), cA + hstep, voffA);
        if (wr == 1) PG8_BAR;
        PG8_WAIT_V(4); PG8_BAR;
        PG8_STAGE(PG8_SB(1, 0), cB + kstep, voffB); PG8_STAGE(PG8_SA(1, 0), cA + kstep, voffA); PG8_STAGE(PG8_SB(1, 1), cB + hstep + kstep, voffB);
        PG8_WAIT_V(6); PG8_BAR;
    }
    for (;;) {
        const bool has_next = S.next(ui + 1, nxt);
        const char* nA = has_next ? (const char*)g.A + (size_t)nxt.pm * tstep : cA; const char* nB = has_next ? (const char*)g.Bt + (size_t)nxt.pn * tstep : cB;
        for (int t = 0; t < nt; t += 2) {
            const bool last = (t == nt - 2);
            const char* a1 = cA + (size_t)(t + 1) * kstep;
            const char* a2 = last ? nA : cA + (size_t)(t + 2) * kstep; const char* b2 = last ? nB : cB + (size_t)(t + 2) * kstep;
            const char* a3 = a2 + kstep; const char* b3 = b2 + kstep;
            if (last && has_next) S.a_ready(nxt);
            if constexpr (SP2) {
            PG8_LDB(B0, 0, 0); PG8_LDB(B1, 0, 1); PG8_SCHED; PG8_LDA(At, 0, 0); PG8_STAGE(PG8_SA(1, 1), a1 + hstep, voffA);
            PG8_WAIT_V(8); PG8_WAIT_L(0); PG8_BAR; PG8_MMA(0, 0, At, B0); PG8_MMA(0, 1, At, B1); PG8_BAR; PG8_SCHED;
            PG8_LDA(At, 0, 1); PG8_STAGE(PG8_SB(0, 0), b2, voffB); PG8_STAGE(PG8_SB(0, 1), b2 + hstep, voffB); PG8_STAGE(PG8_SA(0, 0), a2, voffA);
            PG8_WAIT_V(8); PG8_WAIT_L(0); PG8_BAR; PG8_MMA(1, 0, At, B0); PG8_MMA(1, 1, At, B1); PG8_BAR; PG8_SCHED;
            PG8_LDB(B0, 1, 0); PG8_LDB(B1, 1, 1); PG8_SCHED; PG8_LDA(At, 1, 0); PG8_STAGE(PG8_SA(0, 1), a2 + hstep, voffA);
            PG8_WAIT_V(8); PG8_WAIT_L(0); PG8_BAR; PG8_MMA(0, 0, At, B0); PG8_MMA(0, 1, At, B1); PG8_BAR; PG8_SCHED;
            PG8_LDA(At, 1, 1); PG8_STAGE(PG8_SB(1, 0), b3, voffB); PG8_STAGE(PG8_SB(1, 1), b3 + hstep, voffB); PG8_STAGE(PG8_SA(1, 0), a3, voffA);
            PG8_WAIT_V(8); PG8_WAIT_L(0); PG8_BAR; PG8_MMA(1, 0, At, B0); PG8_MMA(1, 1, At, B1); PG8_BAR; PG8_SCHED;
            } else {
            PG8_LDB(B0, 0, 0); PG8_SCHED; PG8_LDA(At, 0, 0); PG8_STAGE(PG8_SA(1, 1), a1 + hstep, voffA);
            PG8_WAIT_L(8); PG8_BAR; PG8_WAIT_L(0); PG8_MMA(0, 0, At, B0); PG8_BAR; PG8_SCHED;
            PG8_LDB(B1, 0, 1); PG8_STAGE(PG8_SB(0, 0), b2, voffB);
            PG8_BAR; PG8_WAIT_L(0); PG8_MMA(0, 1, At, B1); PG8_BAR;
            PG8_LDA(At, 0, 1); PG8_STAGE(PG8_SA(0, 0), a2, voffA);
            PG8_BAR; PG8_WAIT_L(0); PG8_MMA(1, 0, At, B0); PG8_BAR; PG8_SCHED;
            PG8_STAGE(PG8_SB(0, 1), b2 + hstep, voffB);
            PG8_WAIT_V(6); PG8_BAR; PG8_MMA(1, 1, At, B1); PG8_BAR;
            PG8_LDB(B0, 1, 0); PG8_SCHED; PG8_LDA(At, 1, 0); PG8_STAGE(PG8_SA(0, 1), a2 + hstep, voffA);
            PG8_WAIT_L(8); PG8_BAR; PG8_WAIT_L(0); PG8_MMA(0, 0, At, B0); PG8_BAR; PG8_SCHED;
            PG8_LDB(B1, 1, 1); PG8_STAGE(PG8_SB(1, 0), b3, voffB);
            PG8_BAR; PG8_WAIT_L(0); PG8_MMA(0, 1, At, B1); PG8_BAR;
            PG8_LDA(At, 1, 1); PG8_STAGE(PG8_SA(1, 0), a3, voffA);
            PG8_BAR; PG8_WAIT_L(0); PG8_MMA(1, 0, At, B0); PG8_BAR; PG8_SCHED;
            PG8_STAGE(PG8_SB(1, 1), b3 + hstep, voffB);
            PG8_WAIT_V(6); PG8_BAR; PG8_MMA(1, 1, At, B1); PG8_BAR;
            }
        }
        if constexpr (ALIGN_EPI) { if (wr == 0) PG8_BAR; }
        if constexpr (!Epi::AFTER_DRAIN) { E(acc, cur, wr, wc, fr, fq); S.done(cur); }
        if (!has_next) break;
#pragma unroll
        for (int a = 0; a < 2; ++a)
#pragma unroll
            for (int b = 0; b < 2; ++b)
#pragma unroll
                for (int m = 0; m < 4; ++m)
#pragma unroll
                    for (int n = 0; n < 2; ++n) acc[a][b][m][n] = (f32x4){0.f, 0.f, 0.f, 0.f};
        cur = nxt; cA = nA; cB = nB; ++ui;
        if constexpr (ALIGN_EPI) { if (wr == 1) PG8_BAR; }
    }
    PG8_WAIT_V(0);
    if constexpr (!ALIGN_EPI) { if (wr == 0) PG8_BAR; }
    PG8_BAR;
    if constexpr (Epi::AFTER_DRAIN) { E.fused(acc, cur, wr, wc, fr, fq, lds, wid, lane); S.done(cur); }
#undef PG8_SA
#undef PG8_SB
#undef PG8_STAGE
#undef PG8_LDA
#undef PG8_LDB
#undef PG8_MMA
#undef PG8_WAIT_V
#undef PG8_WAIT_L
#undef PG8_BAR
#undef PG8_SCHED
}
}


constexpr int NWAVES = 8;
constexpr int BATCH = 8, SEQ = 2048, D = 1024, M = BATCH * SEQ, DEPTH = 4, DFF = 2816, NGU = 2 * DFF;
constexpr int EV_N = 4096, EV_IN = 4104, OD_N = 1536, HD = 128, CHUNK = 128;
constexpr float EPS = 1e-6f;
constexpr float KSCALE = 0.08838834764831845f;
constexpr size_t MiB = 1u << 20;
constexpr size_t WS_CTL = 0, CTL_ZERO_BYTES = 65536;
constexpr size_t WS_ROT = 1 * MiB;
constexpr size_t WS_GATES = 2 * MiB;
constexpr size_t WS_WTG = 2 * MiB + 512 * 1024;
constexpr size_t WS_WTP = WS_WTG + 65536;
constexpr size_t WS_SSQ = 3 * MiB;
constexpr size_t WS_WIN_A = 4 * MiB;
constexpr size_t WS_WIN_B = 12 * MiB;
constexpr size_t WS_WOUT = 16 * MiB;
constexpr size_t WS_WGU_A = 24 * MiB, WS_WD_A = 35 * MiB;
constexpr size_t WS_WGU_B = 41 * MiB, WS_WD_B = 52 * MiB;
constexpr size_t WS_XB = 58 * MiB;
constexpr size_t WS_MIXED = 90 * MiB;
constexpr size_t WS_Z = 122 * MiB;
constexpr size_t WS_XQ = WS_Z + 96 * MiB;
constexpr size_t WS_RSQ = WS_Z + 112 * MiB;
constexpr size_t WGU_CS_OFF = 8 * MiB;
constexpr size_t WS_END = 250 * MiB;
constexpr int CW_TMO = 0, CW_CODE = 1, CW_BAR = 4096;
constexpr int RING_OFF = 0, RING_BYTES = 131072;
constexpr int LDSCTL_OFF = RING_BYTES, MISC_OFF = LDSCTL_OFF + 320;
constexpr int LDS_BYTES = 147456;


#define GAS __attribute__((address_space(1)))
#define LAS __attribute__((address_space(3)))
typedef unsigned short bf16;
typedef unsigned v4u __attribute__((ext_vector_type(4)));
typedef float f32x4 __attribute__((ext_vector_type(4)));
typedef short bf16x8 __attribute__((ext_vector_type(8)));
typedef GAS unsigned gu32;
typedef GAS unsigned long long gu64;
#define RLX_AGENT __ATOMIC_RELAXED, __HIP_MEMORY_SCOPE_AGENT
#define LDS_WAIT() asm volatile("s_waitcnt lgkmcnt(0)" ::: "memory")
#define VM_WAIT() asm volatile("s_waitcnt vmcnt(0)" ::: "memory")
__device__ __forceinline__ unsigned long long rt() { return __builtin_amdgcn_s_memrealtime(); }
__device__ __forceinline__ unsigned f2bf(float f) { unsigned u = __builtin_bit_cast(unsigned, f); return (u + 0x7fffu + ((u >> 16) & 1u)) >> 16; }
typedef float f32x2_cv __attribute__((ext_vector_type(2))); typedef __bf16 bf16x2_cv __attribute__((ext_vector_type(2)));
__device__ __forceinline__ unsigned pk2(float lo, float hi) { const f32x2_cv v = {lo, hi}; return __builtin_bit_cast(unsigned, __builtin_convertvector(v, bf16x2_cv)); }

#define XB_TMO      128
#define XB_XCNT(j)  (256  + 64 * (j))
#define XB_XSUB(j)  (1280 + 64 * (j))
#define XB_XGEN(j)  (2304 + 64 * (j))
#define XB_TOP      3328
#define XB_TOPGEN   3392
#define XCD_BAR_WORDS 3456
#define XB_SPIN_CAP (1u << 18)

__device__ __forceinline__ unsigned xb_ld(unsigned* p)              { return __hip_atomic_load(p, __ATOMIC_RELAXED, __HIP_MEMORY_SCOPE_AGENT); }
__device__ __forceinline__ unsigned xb_add(unsigned* p, unsigned v) { return __hip_atomic_fetch_add(p, v, __ATOMIC_RELAXED, __HIP_MEMORY_SCOPE_AGENT); }
__device__ __forceinline__ unsigned xb_xcc_id() { return (unsigned)__builtin_amdgcn_s_getreg((3 << 11) | 20) & 0xFu; }
#define XB_SPIN(cond, bar) do { unsigned _sp = 0; while (cond) { __builtin_amdgcn_s_sleep(0); \
    if ((++_sp & 255u) == 0u) { if (xb_ld(&(bar)[XB_TMO])) break; if (_sp > XB_SPIN_CAP) { atomicAdd(&(bar)[XB_TMO], 1u); break; } } } } while (0)

struct XcdBarrier {
    unsigned* bar; unsigned x;
    volatile LAS unsigned* st;
};

__device__ __forceinline__ XcdBarrier xcd_barrier_post(unsigned* bar, volatile LAS unsigned* st, int tid_b) {
    XcdBarrier b; b.bar = bar; b.x = xb_xcc_id(); b.st = st;
    if (tid_b == 0) (void)xb_add(&bar[XB_XCNT(b.x)], 1u);
    return b;
}
__device__ __forceinline__ void xcd_barrier_complete(unsigned* bar, unsigned x, unsigned& nloc, unsigned& nx) {
    const unsigned G = gridDim.x * gridDim.y * gridDim.z;
    unsigned sum, cnt, mine, sp = 0u;
    for (;;) {
        sum = 0u; cnt = 0u; mine = 0u;
#pragma unroll
        for (unsigned j = 0; j < 16; ++j) { const unsigned c = xb_ld(&bar[XB_XCNT(j)]); sum += c; cnt += (c > 0u) ? 1u : 0u; mine = (j == x) ? c : mine; }
        if (sum == G) break;
        __builtin_amdgcn_s_sleep(1);
        if ((++sp & 255u) == 0u) { if (xb_ld(&bar[XB_TMO])) break; if (sp > XB_SPIN_CAP) { atomicAdd(&bar[XB_TMO], 1u); break; } }
    }
    nloc = mine > 0u ? mine : 1u; nx = cnt > 0u ? cnt : 1u;
}

__device__ __forceinline__ void xcd_barrier(const XcdBarrier& b, int tid_b) {
    asm volatile("s_waitcnt vmcnt(0)" ::: "memory");
    __syncthreads();
    if (tid_b == 0) {
        unsigned* bar = b.bar;
        __builtin_amdgcn_s_waitcnt(0);
        unsigned nloc = b.st[0], nx = b.st[1];
        if (nloc == 0u) { xcd_barrier_complete(bar, b.x, nloc, nx); b.st[0] = nloc; b.st[1] = nx; }
        const unsigned old = xb_add(&bar[XB_XSUB(b.x)], 1u);
        const unsigned gen = old / nloc;
        if (old + 1u == (gen + 1u) * nloc) {
            __builtin_amdgcn_fence(__ATOMIC_RELEASE, "agent");
            asm volatile("s_waitcnt vmcnt(0)" ::: "memory");
            const unsigned og = xb_add(&bar[XB_TOP], 1u);
            const unsigned tg = og / nx;
            if (og + 1u == (tg + 1u) * nx) xb_add(&bar[XB_TOPGEN], 1u);
            else XB_SPIN(xb_ld(&bar[XB_TOPGEN]) == tg, bar);
            __builtin_amdgcn_fence(__ATOMIC_ACQUIRE, "agent");
            xb_add(&bar[XB_XGEN(b.x)], 1u);
            asm volatile("s_waitcnt vmcnt(0)" ::: "memory");
        } else {
            XB_SPIN(xb_ld(&bar[XB_XGEN(b.x)]) == gen, bar);
            __builtin_amdgcn_fence(__ATOMIC_ACQUIRE, "agent");
            asm volatile("s_waitcnt vmcnt(0)" ::: "memory");
        }
    }
    __syncthreads();
}


__device__ __forceinline__ int hw_lane() { int l; asm volatile("v_mbcnt_lo_u32_b32 %0, -1, 0\n\tv_mbcnt_hi_u32_b32 %0, -1, %0" : "=v"(l)); return l; }
__device__ __forceinline__ float bf2f(bf16 u) { return __builtin_bit_cast(float, (unsigned)u << 16); }
__device__ __forceinline__ float wave_sum(float v, int lane) {
    v += sx<1>(v, lane); v += sx<2>(v, lane); v += sx<4>(v, lane); v += sx<8>(v, lane); v += sx<16>(v, lane); v += sx<32>(v, lane);
    return v;
}
__device__ __forceinline__ float sigmoidf_(float x) { return __builtin_amdgcn_rcpf(1.0f + __builtin_amdgcn_exp2f(-1.4426950408889634f * x)); }
__device__ __forceinline__ float block_sum(float v, LAS float* buf, int wave, int lane) {
    v = wave_sum(v, lane); if (lane == 0) buf[wave] = v; __syncthreads();
    float s = 0.f;
#pragma unroll
    for (int i = 0; i < NWAVES; ++i) s += buf[i];
    __syncthreads(); return s;
}

__device__ __forceinline__ void tr_item(const float* W, int ldw, int c0, const float* gs, bf16* WT, int ldk, int drow, LAS float* scr, int k0, int n0, int lane) {
    const float* src = W + (size_t)(k0 + (lane >> 5)) * ldw + c0 + n0 + (lane & 31); float v[32];
    const float g = gs ? gs[k0 + lane] : 1.0f;
#pragma unroll
    for (int i = 0; i < 32; ++i) v[i] = src[(size_t)(2 * i) * ldw];
#pragma unroll
    for (int i = 0; i < 32; ++i) { const float g0 = __builtin_bit_cast(float, __builtin_amdgcn_readlane(__builtin_bit_cast(int, g), 2 * i)), g1 = __builtin_bit_cast(float, __builtin_amdgcn_readlane(__builtin_bit_cast(int, g), 2 * i + 1));
        scr[(2 * i + (lane >> 5)) * 33 + (lane & 31)] = v[i] * (lane < 32 ? g0 : g1); }
    LDS_WAIT(); asm volatile("" ::: "memory");
    const int c = lane & 7;
#pragma unroll
    for (int j = 0; j < 4; ++j) { const int n = (lane >> 3) + 8 * j; const LAS float* s = scr + (8 * c) * 33 + n;
        v4u o; o.x = pk2(s[0 * 33], s[1 * 33]); o.y = pk2(s[2 * 33], s[3 * 33]); o.z = pk2(s[4 * 33], s[5 * 33]); o.w = pk2(s[6 * 33], s[7 * 33]);
        *(GAS v4u*)(WT + (size_t)(drow + n0 + n) * ldk + k0 + 8 * c) = o; }
    LDS_WAIT(); asm volatile("" ::: "memory");
}
typedef const __attribute__((address_space(4))) char* kaptr_t;
__device__ __forceinline__ kaptr_t karg() { kaptr_t p = (kaptr_t)__builtin_amdgcn_kernarg_segment_ptr(); asm volatile("" : "+s"(p)); return p; }
struct Ptrs {
    __device__ __forceinline__ const float* in(int k) const { return *(const float* const __attribute__((address_space(4)))*)(karg() + 8 * k); }
#define PF(name, k) __device__ __forceinline__ const float* name() const { return in(k); }
    PF(x, 0) PF(g_mix, 1) PF(g_ffn, 2) PF(g_fin, 3) PF(ev_w_in, 4) PF(ev_cw, 5) PF(ev_cb, 6) PF(ev_ib, 7) PF(ev_fb, 8) PF(ev_ngm, 9) PF(ev_ngr, 10) PF(ev_w_out, 11)
    PF(od_w_in, 12) PF(od_pw, 13) PF(od_ps, 14) PF(od_dw, 15) PF(od_db, 16) PF(od_ng, 17) PF(od_nb, 18) PF(od_w_out, 19) PF(w_gate, 20) PF(w_up, 21) PF(w_down, 22)
#undef PF
    __device__ __forceinline__ float* out() const { return *(float* const __attribute__((address_space(4)))*)(karg() + 184); }
    __device__ __forceinline__ unsigned char* ws() const { return *(unsigned char* const __attribute__((address_space(4)))*)(karg() + 192); }
    __device__ __forceinline__ int ph_lo() const { return *(const __attribute__((address_space(4))) int*)(karg() + 200); }
    __device__ __forceinline__ int ph_hi() const { return *(const __attribute__((address_space(4))) int*)(karg() + 204); }
};
__device__ __forceinline__ void cv_in(const Ptrs& P, int L, LAS float* scr, int gw, int NGW, int lane) {
    const int j = L >> 1; const bool even = (L & 1) == 0; const float* gm = P.g_mix() + L * D;
    bf16* WIN = (bf16*)(P.ws() + (even ? WS_WIN_A : WS_WIN_B));
    const float* Win = even ? P.ev_w_in() + (size_t)j * D * EV_IN : P.od_w_in() + (size_t)j * D * OD_N;
    const int ldin = even ? EV_IN : OD_N, nblk = even ? 64 : 48, I_INA = 16 * nblk, I_INB = even ? 16 * 64 : 0;
    for (int it = gw; it < I_INA + I_INB; it += NGW) {
        if (it < I_INA) tr_item(Win, ldin, 0, gm, WIN, D, 0, scr, 64 * (it / nblk), 32 * (it % nblk), lane);
        else { const int r = it - I_INA; tr_item(Win, ldin, 2056, gm, WIN, D, 2048, scr, 64 * (r / 64), 32 * (r % 64), lane); } }
    if (even) { bf16* WTG = (bf16*)(P.ws() + WS_WTG);
#pragma clang loop vectorize(disable) unroll(disable)
        for (int idx = gw * 64 + lane; idx < 8 * D; idx += NGW * 64) { const int c = idx >> 10, k = idx & 1023; WTG[idx] = (bf16)f2bf(gm[k] * Win[(size_t)k * EV_IN + 2048 + c]); } }
}
__device__ __forceinline__ void cv_out(const Ptrs& P, int L, LAS float* scr, int gw, int NGW, int lane) {
    const int j = L >> 1; const bool even = (L & 1) == 0;
    const float* Wout = even ? P.ev_w_out() + (size_t)j * D * D : P.od_w_out() + (size_t)j * D * D; bf16* WOUT = (bf16*)(P.ws() + WS_WOUT) + (size_t)L * D * D;
    const int I_OUT = 16 * 32, I_POOL = even ? 0 : 32;
    for (int it = gw; it < I_OUT + I_POOL; it += NGW) {
        if (it < I_OUT) tr_item(Wout, D, 0, nullptr, WOUT, D, 0, scr, 64 * (it / 32), 32 * (it % 32), lane);
        else { const int r = it - I_OUT, g = r >> 3, q = r & 7; tr_item(P.od_pw() + (size_t)(j * 4 + g) * 128 * 128, 128, 0, nullptr, (bf16*)(P.ws() + WS_WTP) + g * 128 * 128, 128, 0, scr, 64 * (q >> 2), 32 * (q & 3), lane); } }
}
__device__ __forceinline__ void cvq_gu_item(const float* W, const float* gs, signed char* WQ, float* cs, int drow, LAS unsigned char* lds, int n0, int wave, int lane) {
    LAS float* scr = (LAS float*)(lds + RING_OFF + wave * 16384);
    float v[2][32]; float m = 0.f;
#pragma unroll
    for (int t = 0; t < 2; ++t) { const int k0 = 64 * (2 * wave + t); const float* src = W + (size_t)(k0 + (lane >> 5)) * DFF + n0 + (lane & 31); const float g = gs[k0 + lane];
#pragma unroll
        for (int i = 0; i < 32; ++i) v[t][i] = __builtin_nontemporal_load(src + (size_t)(2 * i) * DFF);
#pragma unroll
        for (int i = 0; i < 32; ++i) { const float g0 = __builtin_bit_cast(float, __builtin_amdgcn_readlane(__builtin_bit_cast(int, g), 2 * i)), g1 = __builtin_bit_cast(float, __builtin_amdgcn_readlane(__builtin_bit_cast(int, g), 2 * i + 1));
            v[t][i] *= (lane < 32 ? g0 : g1); m = fmaxf(m, fabsf(v[t][i])); } }
    m = fmaxf(m, sx<32>(m, lane));
    if (lane < 32) *(LAS float*)(lds + RING_OFF + wave * 16384 + 12288 + 4 * lane) = m;
    __syncthreads();
    float cmax = 0.f;
#pragma unroll
    for (int w = 0; w < NWAVES; ++w) cmax = fmaxf(cmax, *(const LAS float*)(lds + RING_OFF + w * 16384 + 12288 + 4 * (lane & 31)));
    const float qs = cmax > 0.f ? 127.0f / cmax : 0.f;
    if (wave == 0 && lane < 32) cs[drow + n0 + lane] = cmax * (1.0f / 127.0f);
#pragma unroll
    for (int t = 0; t < 2; ++t) { const int k0 = 64 * (2 * wave + t);
#pragma unroll
        for (int i = 0; i < 32; ++i) scr[(2 * i + (lane >> 5)) * 33 + (lane & 31)] = __builtin_rintf(v[t][i] * qs);
        LDS_WAIT(); asm volatile("" ::: "memory");
        const int c = lane & 7;
#pragma unroll
        for (int j = 0; j < 4; ++j) { const int n = (lane >> 3) + 8 * j; const LAS float* sp = scr + (8 * c) * 33 + n; unsigned lo = 0u, hi = 0u;
#pragma unroll
            for (int q = 0; q < 4; ++q) { lo |= ((unsigned)(int)sp[q * 33] & 0xffu) << (8 * q); hi |= ((unsigned)(int)sp[(4 + q) * 33] & 0xffu) << (8 * q); }
            pg8::u32x2 o2; o2.x = lo; o2.y = hi; *(GAS pg8::u32x2*)(WQ + (size_t)(drow + n0 + n) * 1024 + k0 + 8 * c) = o2; }
        LDS_WAIT(); asm volatile("" ::: "memory"); }
    __syncthreads();
}
__device__ __forceinline__ void cv_ffn(const Ptrs& P, int L, LAS unsigned char* lds, LAS float* scr, int gw, int NGW, int lane) {
    const bool even = (L & 1) == 0; const float* gf = P.g_ffn() + L * D;
    unsigned char* WGU = P.ws() + (even ? WS_WGU_A : WS_WGU_B); bf16* WD = (bf16*)(P.ws() + (even ? WS_WD_A : WS_WD_B));
    const float* Wg = P.w_gate() + (size_t)L * D * DFF; const float* Wu = P.w_up() + (size_t)L * D * DFF; const float* Wd = P.w_down() + (size_t)L * DFF * D;
    const int wb = gw >> 3, NWB = NGW >> 3, wave = gw & 7;
    for (int it = wb; it < 2 * 88; it += NWB) { const int up = it >= 88, n0 = 32 * (it - up * 88);
        cvq_gu_item(up ? Wu : Wg, gf, (signed char*)WGU, (float*)(WGU + WGU_CS_OFF), (n0 >> 7) * 256 + (n0 & 127) + up * 128 - n0, lds, n0, wave, lane); }
    const int I_D = 44 * 32;
    for (int it = gw; it < I_D; it += NGW) tr_item(Wd, D, 0, nullptr, WD, DFF, 0, scr, 64 * (it / 32), 32 * (it % 32), lane);
}
__device__ __forceinline__ void quant_rows(const Ptrs& P, int gw, int NGW, int lane) {
    const bf16* XBp = (const bf16*)(P.ws() + WS_XB); unsigned char* XQ = P.ws() + WS_XQ; float* RSQ = (float*)(P.ws() + WS_RSQ);
    for (int m0 = gw; m0 < M; m0 += 4 * NGW) {
        v4u w[4][2];
#pragma unroll
        for (int rr = 0; rr < 4; ++rr) { const int m = m0 + rr * NGW; if (m < M) { const GAS v4u* xr = (const GAS v4u*)(XBp + (size_t)m * D) + 2 * lane; w[rr][0] = xr[0]; w[rr][1] = xr[1]; } }
#pragma unroll
        for (int rr = 0; rr < 4; ++rr) { const int m = m0 + rr * NGW; if (m < M) {
            float x[16]; float am = 0.f, ss = 0.f;
#pragma unroll
            for (int q = 0; q < 2; ++q)
#pragma unroll
                for (int e = 0; e < 4; ++e) { x[8 * q + 2 * e] = __builtin_bit_cast(float, w[rr][q][e] << 16); x[8 * q + 2 * e + 1] = __builtin_bit_cast(float, w[rr][q][e] & 0xffff0000u); }
#pragma unroll
            for (int k = 0; k < 16; ++k) { am = fmaxf(am, fabsf(x[k])); ss += x[k] * x[k]; }
            am = fmaxf(am, sx<1>(am, lane)); am = fmaxf(am, sx<2>(am, lane)); am = fmaxf(am, sx<4>(am, lane)); am = fmaxf(am, sx<8>(am, lane)); am = fmaxf(am, sx<16>(am, lane)); am = fmaxf(am, sx<32>(am, lane));
            ss = wave_sum(ss, lane);
            const float inv = am > 0.f ? 127.0f / am : 0.f; v4u o;
#pragma unroll
            for (int q = 0; q < 4; ++q) { unsigned u = 0u;
#pragma unroll
                for (int e = 0; e < 4; ++e) u |= ((unsigned)(int)__builtin_rintf(x[4 * q + e] * inv) & 0xffu) << (8 * e);
                o[q] = u; }
            *(GAS v4u*)(XQ + (size_t)m * D + 16 * lane) = o;
            if (lane == 0) RSQ[m] = __builtin_amdgcn_rsqf(ss * (1.0f / D) + EPS) * am * (1.0f / 127.0f); } }
    }
}
__device__ __forceinline__ void prologue_rows(const Ptrs& P, int gw, int NGW, int lane) {
    bf16* XB = (bf16*)(P.ws() + WS_XB); float* SSQ = (float*)(P.ws() + WS_SSQ); float* ROT = (float*)(P.ws() + WS_ROT);
    for (int m = gw; m < M; m += NGW) {
        const GAS f32x4* xr = (const GAS f32x4*)(P.x() + (size_t)m * D) + lane; GAS unsigned long long* o8 = (GAS unsigned long long*)(XB + (size_t)m * D) + lane;
        float s = 0.f;
#pragma unroll
        for (int q = 0; q < 4; ++q) { const f32x4 v = xr[64 * q]; s += (v.x * v.x + v.y * v.y) + (v.z * v.z + v.w * v.w); o8[64 * q] = (unsigned long long)pk2(v.x, v.y) | ((unsigned long long)pk2(v.z, v.w) << 32); }
        s = wave_sum(s, lane);
        if (lane < 16) SSQ[(size_t)m * 16 + lane] = lane == 0 ? s : 0.f;
    }
    for (int t = gw; t < SEQ; t += NGW) {
        const float inv = powf(10000.0f, -(float)(2 * lane) / 128.0f); const float ang = (float)t * inv; float sn, cs; sincosf(ang, &sn, &cs);
        ROT[((size_t)t * 64 + lane) * 2] = cs; ROT[((size_t)t * 64 + lane) * 2 + 1] = sn;
    }
}
__device__ __forceinline__ void final_norm(const Ptrs& P, int gw, int NGW, int lane) {
    const bf16* XBp = (const bf16*)(P.ws() + WS_XB);
    for (int m = gw; m < M; m += NGW) {
        const GAS v4u* xr = (const GAS v4u*)(XBp + (size_t)m * D) + lane; GAS f32x4* orow = (GAS f32x4*)(P.out() + (size_t)m * D); const GAS f32x4* gr = (const GAS f32x4*)P.g_fin();
        float v[16]; float s = 0.f;
#pragma unroll
        for (int q = 0; q < 2; ++q) { const v4u w = xr[64 * q];
#pragma unroll
            for (int e = 0; e < 4; ++e) { v[8 * q + 2 * e] = __builtin_bit_cast(float, w[e] << 16); v[8 * q + 2 * e + 1] = __builtin_bit_cast(float, w[e] & 0xffff0000u); } }
#pragma unroll
        for (int k = 0; k < 16; ++k) s += v[k] * v[k];
        const float rs = __builtin_amdgcn_rsqf(wave_sum(s, lane) * (1.0f / D) + EPS);
#pragma unroll
        for (int q = 0; q < 2; ++q)
#pragma unroll
            for (int hq = 0; hq < 2; ++hq) { const int idx = 2 * (lane + 64 * q) + hq; const f32x4 g = gr[idx];
                orow[idx] = (f32x4){v[8 * q + 4 * hq] * rs * g.x, v[8 * q + 4 * hq + 1] * rs * g.y, v[8 * q + 4 * hq + 2] * rs * g.z, v[8 * q + 4 * hq + 3] * rs * g.w}; }
    }
}
__device__ __forceinline__ void gates_rows(const Ptrs& P, int j, int gw, int NGW, int lane) {
    const bf16* XB = (const bf16*)(P.ws() + WS_XB); const bf16* WTG = (const bf16*)(P.ws() + WS_WTG); const float* SSQ = (const float*)(P.ws() + WS_SSQ); float* GATES = (float*)(P.ws() + WS_GATES);
    const int r16 = lane & 15, kq = lane >> 4; const float bias = r16 < 4 ? P.ev_ib()[j * 4 + r16] : (r16 < 8 ? P.ev_fb()[j * 4 + r16 - 4] : 0.f);
    for (int grp = gw; grp < M / 16; grp += NGW) {
        const GAS v4u* a = (const GAS v4u*)(XB + (size_t)(grp * 16 + r16) * D + 8 * kq); const GAS v4u* w = (const GAS v4u*)(WTG + (size_t)(r16 & 7) * D + 8 * kq);
        pg8::f32x4 acc = (pg8::f32x4){0.f, 0.f, 0.f, 0.f};
#pragma unroll 8
        for (int s2 = 0; s2 < D / 32; ++s2) { const v4u av = a[4 * s2]; v4u wv = w[4 * s2]; if (r16 >= 8) wv = (v4u){0u, 0u, 0u, 0u};
            acc = __builtin_amdgcn_mfma_f32_16x16x32_bf16(__builtin_bit_cast(bf16x8, av), __builtin_bit_cast(bf16x8, wv), acc, 0, 0, 0); }
        const f32x4 p = *(const GAS f32x4*)(SSQ + (size_t)(grp * 16 + r16) * 16 + 4 * kq); float sq = (p.x + p.y) + (p.z + p.w);
        sq += sx<16>(sq, lane); sq += sx<32>(sq, lane);
        const float rs = __builtin_amdgcn_rsqf(sq * (1.0f / D) + EPS);
#pragma unroll
        for (int e = 0; e < 4; ++e) { const float rr = __builtin_bit_cast(float, __builtin_amdgcn_ds_bpermute((4 * kq + e) << 2, __builtin_bit_cast(int, rs)));
            if (r16 < 8) GATES[(size_t)(grp * 16 + 4 * kq + e) * 8 + r16] = acc[e] * rr + bias; }
    }
}

typedef float f32x2v __attribute__((ext_vector_type(2)));
typedef float f32x16 __attribute__((ext_vector_type(16)));
__device__ __forceinline__ f32x2v unpk2(unsigned w) { f32x2v r; r.x = __builtin_bit_cast(float, w << 16); r.y = __builtin_bit_cast(float, w & 0xffff0000u); return r; }
__device__ __forceinline__ int crow(int reg, int h) { return (reg & 3) + 8 * (reg >> 2) + 4 * h; }
template <int N, int DIST> __device__ __forceinline__ void bfly_step(const float (&v)[N], float (&r)[N / 2], int lane) {
    const bool up = (lane & DIST) != 0;
#pragma unroll
    for (int i = 0; i < N / 2; ++i) { const float send = up ? v[i] : v[i + N / 2], keep = up ? v[i + N / 2] : v[i]; r[i] = keep + sx<DIST>(send, lane); }
}
__device__ __forceinline__ float bfly32(const float (&v)[32], int lane) {
    float a[16], b[8], c[4], d[2], e[1];
    bfly_step<32, 32>(v, a, lane); bfly_step<16, 16>(a, b, lane); bfly_step<8, 8>(b, c, lane); bfly_step<4, 4>(c, d, lane); bfly_step<2, 2>(d, e, lane);
    return e[0] + sx<1>(e[0], lane);
}
constexpr int OD_Y_ROWS = 94, OD_U_ROWS = 79, OD_WP_OFF = OD_Y_ROWS * 1024, OD_MS_OFF = OD_WP_OFF + 2048, OD_PL_STRIDE = 1040;
__device__ __forceinline__ void od_fast_item(const Ptrs& P, int j, LAS unsigned char* lds, int item, int tid_in) {
    int tid = tid_in; asm volatile("" : "+v"(tid));
    const bf16* Z = (const bf16*)(P.ws() + WS_Z); bf16* MIXED = (bf16*)(P.ws() + WS_MIXED);
    const int row0 = item * 64, t0 = row0 & (SEQ - 1), lane = tid & 63, wv = tid >> 6;
    const bf16* zt = Z + (size_t)row0 * OD_N;
    for (int idx = tid; idx < OD_Y_ROWS * 64; idx += NWAVES * 64) { const int r = idx >> 6, ch = idx & 63, trel = r - 30; v4u o = (v4u){0u, 0u, 0u, 0u};
        if (t0 + trel >= 0) { const bf16* zr = zt + (long)trel * OD_N + 8 * ch; const v4u ga = *(const GAS v4u*)(zr + 512), gb = *(const GAS v4u*)(zr + 1024);
#pragma unroll
            for (int e = 0; e < 4; ++e) { const f32x2v a = unpk2(ga[e]), b = unpk2(gb[e]); o[e] = pk2(a.x * sigmoidf_(b.x), a.y * sigmoidf_(b.y)); } }
        *(LAS v4u*)(lds + r * 1024 + ch * 16) = o; }
    __syncthreads();
    const int cp = tid & 255, th = tid >> 8;
    f32x2v acc[32];
    {
        const float* dw = P.od_dw() + (size_t)j * 31 * 512 + 2 * cp; f32x2v w[31];
#pragma unroll
        for (int k = 0; k < 31; ++k) w[k] = *(const GAS f32x2v*)(dw + k * 512);
        const f32x2v bias = *(const GAS f32x2v*)(P.od_db() + j * 512 + 2 * cp);
#pragma unroll
        for (int t = 0; t < 32; ++t) acc[t] = bias;
        const LAS unsigned char* yb = lds + (32 * th) * 1024 + 4 * cp;
#pragma unroll
        for (int r = 0; r < 62; ++r) { const f32x2v y = unpk2(*(const LAS unsigned*)(yb + r * 1024));
#pragma unroll
            for (int t = (r > 30 ? r - 30 : 0); t <= (r < 31 ? r : 31); ++t) acc[t] += w[r - t] * y;
            if ((r & 3) == 3) asm volatile("" ::: "memory"); }
    }
    {
        float s1[32], s2[32];
#pragma unroll
        for (int t = 0; t < 32; ++t) { s1[t] = acc[t].x + acc[t].y; s2[t] = acc[t].x * acc[t].x + acc[t].y * acc[t].y; }
        const float t1 = bfly32(s1, lane), t2 = bfly32(s2, lane);
        if ((lane & 1) == 0) *(LAS f32x2v*)(lds + OD_WP_OFF + (wv * 32 + (lane >> 1)) * 8) = (f32x2v){t1, t2};
    }
    __syncthreads();
    if (tid < 64) { const int th_ = tid >> 5, tk = tid & 31; f32x2v a = (f32x2v){0.f, 0.f};
#pragma unroll
        for (int w4 = 0; w4 < 4; ++w4) a += *(const LAS f32x2v*)(lds + OD_WP_OFF + ((th_ * 4 + w4) * 32 + tk) * 8);
        const float mean = a.x * (1.0f / 512.0f), var = fmaxf(a.y * (1.0f / 512.0f) - mean * mean, 0.f);
        *(LAS f32x2v*)(lds + OD_MS_OFF + tid * 8) = (f32x2v){mean, __builtin_amdgcn_rsqf(var + EPS)}; }
    __syncthreads();
    {
        const f32x2v g2 = *(const GAS f32x2v*)(P.od_ng() + j * 512 + 2 * cp), b2 = *(const GAS f32x2v*)(P.od_nb() + j * 512 + 2 * cp);
        bf16* mo = MIXED + (size_t)(row0 + 32 * th) * D + 512 + 2 * cp; const LAS unsigned char* msb = lds + OD_MS_OFF + (32 * th) * 8;
#pragma unroll
        for (int t = 0; t < 32; ++t) { const f32x2v ms = *(const LAS f32x2v*)(msb + t * 8);
            f32x2v y = (acc[t] - ms.x) * ms.y * g2 + b2; y.x *= sigmoidf_(y.x); y.y *= sigmoidf_(y.y);
            *(GAS unsigned*)mo = pk2(y.x, y.y); mo += D; asm volatile("" : "+v"(mo)); }
    }
    for (int idx = tid; idx < OD_U_ROWS * 64; idx += NWAVES * 64) { const int r = idx >> 6, ch = idx & 63, trel = r - 15; v4u o = (v4u){0u, 0u, 0u, 0u};
        if (t0 + trel >= 0) o = *(const GAS v4u*)(zt + (long)trel * OD_N + 8 * ch);
        *(LAS v4u*)(lds + r * 1024 + ch * 16) = o; }
    __syncthreads();
    {
        const int w = 2 << (cp >> 6); f32x2v S = (f32x2v){0.f, 0.f}, pooled[32];
        const LAS unsigned char* pb = lds + (32 * th + 15) * 1024 + 4 * cp; const LAS unsigned char* pwb = pb - w * 1024;
        for (int k = 0; k < w; ++k) S += unpk2(*(const LAS unsigned*)(pb - k * 1024));
#pragma unroll
        for (int t = 0; t < 32; ++t) { const f32x2v cur = unpk2(*(const LAS unsigned*)(pb + t * 1024));
            if (t > 0) S += cur - unpk2(*(const LAS unsigned*)(pwb + t * 1024));
            const int tp1 = t0 + 32 * th + t + 1; const float ic = __builtin_amdgcn_rcpf((float)(tp1 < w ? tp1 : w));
            pooled[t] = S * ic - cur; }
        __syncthreads();
        { LAS unsigned char* plb = lds + (32 * th) * OD_PL_STRIDE + 4 * cp;
#pragma unroll
        for (int t = 0; t < 32; ++t) *(LAS unsigned*)(plb + t * OD_PL_STRIDE) = pk2(pooled[t].x, pooled[t].y); }
    }
    __syncthreads();
    {
        const int g = wv >> 1, tt = wv & 1, r = lane & 31, hh = lane >> 5;
        const bf16* WTP = (const bf16*)(P.ws() + WS_WTP) + (size_t)g * 128 * 128;
        f32x16 c4[4];
#pragma unroll
        for (int ot = 0; ot < 4; ++ot)
#pragma unroll
            for (int i = 0; i < 16; ++i) c4[ot][i] = 0.f;
#pragma unroll
        for (int s = 0; s < 8; ++s) { const bf16x8 a = *(const LAS bf16x8*)(lds + (32 * tt + r) * OD_PL_STRIDE + g * 256 + s * 32 + hh * 16);
#pragma unroll
            for (int ot = 0; ot < 4; ++ot) { const bf16x8 b = *(const GAS bf16x8*)(WTP + (size_t)(32 * ot + r) * 128 + 16 * s + 8 * hh);
                c4[ot] = __builtin_amdgcn_mfma_f32_32x32x16_bf16(a, b, c4[ot], 0, 0, 0); } }
#pragma unroll
        for (int ot = 0; ot < 4; ++ot) { const float ps = P.od_ps()[j * 512 + g * 128 + 32 * ot + r];
#pragma unroll
            for (int i = 0; i < 16; ++i) { bf16* q = MIXED + (size_t)(row0 + 32 * tt + 4 * hh) * D + g * 128 + 32 * ot + r; asm volatile("" : "+v"(q)); q[(size_t)((i & 3) + 8 * (i >> 2)) * D] = (bf16)f2bf(c4[ot][i] * ps); } }
    }
    __syncthreads();
}

typedef short v4i16_t __attribute__((ext_vector_type(4)));
typedef unsigned u32x2 __attribute__((ext_vector_type(2)));
constexpr int EV_Q = 0, EV_K = 32768, EV_VT = 65536, EV_CT = 98304, EV_SC = 132096;
constexpr int SC_G = 0, SC_RF = 512, SC_INT = 1024, SC_EMM = 1536, SC_PAR = 2048, SC_QN = 4096, SC_N = 4608, SC_NP = 5120, SC_SS = 9216;
__device__ __forceinline__ unsigned offb(unsigned row, unsigned ch) { return 256u * row + 16u * (ch ^ (((row & 3u) << 2) | ((row >> 2) & 3u))); }
__device__ __forceinline__ bf16x8 tr_frag(LAS unsigned char* img, int lane, int c, int ks) {
    const unsigned h = lane >> 5, blk = (lane >> 4) & 1, q = (lane & 15) >> 2, p = lane & 3;
    const v4i16_t lo = __builtin_amdgcn_ds_read_tr16_b64_v4i16((LAS v4i16_t*)(img + offb(16 * ks + 8 * h + q, 4 * c + 2 * blk + (p >> 1)) + 8 * (p & 1)));
    const v4i16_t hi = __builtin_amdgcn_ds_read_tr16_b64_v4i16((LAS v4i16_t*)(img + offb(16 * ks + 8 * h + 4 + q, 4 * c + 2 * blk + (p >> 1)) + 8 * (p & 1)));
    return (bf16x8){lo[0], lo[1], lo[2], lo[3], hi[0], hi[1], hi[2], hi[3]};
}
__device__ __forceinline__ void unpk8(const v4u w, float (&o)[8]) {
#pragma unroll
    for (int e = 0; e < 4; ++e) { o[2 * e] = __builtin_bit_cast(float, w[e] << 16); o[2 * e + 1] = __builtin_bit_cast(float, w[e] & 0xffff0000u); }
}
__device__ __forceinline__ v4u pk8(const float (&o)[8]) { v4u w; w.x = pk2(o[0], o[1]); w.y = pk2(o[2], o[3]); w.z = pk2(o[4], o[5]); w.w = pk2(o[6], o[7]); return w; }
__device__ __forceinline__ float siluf_(float x) { return x * sigmoidf_(x); }
constexpr int SC_WL = 9232, SC_NG = SC_WL + 5120;
__device__ __forceinline__ void conv4_silu_pre(const v4u (&raw)[7], const LAS unsigned char* wl, int dc, float (&out)[4][8]) {
    float w[5][8];
#pragma unroll
    for (int tap = 0; tap < 5; ++tap) { const f32x4 a = *(const LAS f32x4*)(wl + (tap * 128 + 8 * dc) * 4), b = *(const LAS f32x4*)(wl + (tap * 128 + 8 * dc + 4) * 4);
        w[tap][0] = a.x; w[tap][1] = a.y; w[tap][2] = a.z; w[tap][3] = a.w; w[tap][4] = b.x; w[tap][5] = b.y; w[tap][6] = b.z; w[tap][7] = b.w; }
#pragma unroll
    for (int jj = 0; jj < 4; ++jj)
#pragma unroll
        for (int e = 0; e < 8; ++e) out[jj][e] = w[4][e];
#pragma unroll
    for (int rr = 0; rr < 7; ++rr) { float x[8]; unpk8(raw[rr], x);
#pragma unroll
        for (int jj = 0; jj < 4; ++jj) { const int tap = rr - jj; if (tap >= 0 && tap < 4) {
#pragma unroll
            for (int e = 0; e < 8; ++e) out[jj][e] += w[tap][e] * x[e]; } } }
#pragma unroll
    for (int jj = 0; jj < 4; ++jj)
#pragma unroll
        for (int e = 0; e < 8; ++e) out[jj][e] = siluf_(out[jj][e]);
}
__device__ __forceinline__ void rot4_pre(const v4u (&raw)[4], const f32x4 (&cs)[16], int dc, int lane, float (&out)[4][8]) {
#pragma unroll
    for (int jj = 0; jj < 4; ++jj) { v4u pr; pr.x = sxu<8>(raw[jj].x, lane); pr.y = sxu<8>(raw[jj].y, lane); pr.z = sxu<8>(raw[jj].z, lane); pr.w = sxu<8>(raw[jj].w, lane);
        float x[8], xp[8]; unpk8(raw[jj], x); unpk8(pr, xp);
#pragma unroll
        for (int e2 = 0; e2 < 4; ++e2) { const f32x4 c4 = cs[4 * jj + e2];
            out[jj][2 * e2] = dc < 8 ? x[2 * e2] * c4.x - xp[2 * e2] * c4.y : xp[2 * e2] * c4.y + x[2 * e2] * c4.x;
            out[jj][2 * e2 + 1] = dc < 8 ? x[2 * e2 + 1] * c4.z - xp[2 * e2 + 1] * c4.w : xp[2 * e2 + 1] * c4.w + x[2 * e2 + 1] * c4.z; } }
}
template <bool RET>
__device__ __forceinline__ void ev_fast_item(const Ptrs& P, int jl, LAS unsigned char* lds, int item, int tid_in) {
    int tid0 = tid_in; asm volatile("" : "+v"(tid0));
    const bf16* Z = (const bf16*)(P.ws() + WS_Z);
    const int b = (item >> 2) & 7, h = item & 3;
    LAS unsigned char* sc = lds + EV_SC;
    constexpr int NRAW = RET ? 4 : 7;
    constexpr int COL_K = RET ? 2560 : 512, COL_Q = RET ? 2048 : 0, COL_V = RET ? 3072 : 1024, COL_G = RET ? 3584 : 1536;
    for (int k = tid0 * 16; k < 32768; k += NWAVES * 64 * 16) *(LAS v4u*)(lds + EV_CT + k) = (v4u){0u, 0u, 0u, 0u};
    if (tid0 < 128) { *(LAS float*)(sc + SC_N + 4 * tid0) = 0.f; *(LAS float*)(sc + SC_NG + 4 * tid0) = (RET ? P.ev_ngr() : P.ev_ngm())[jl * 512 + h * 128 + tid0]; }
    if (!RET && tid0 < 256) { const int isq = tid0 >> 7, d = tid0 & 127, ch = (isq ? 512 : 0) + h * 128 + d; const float* cw = P.ev_cw() + (size_t)jl * 4096;
#pragma unroll
        for (int tap = 0; tap < 4; ++tap) *(LAS float*)(sc + SC_WL + ((isq * 5 + tap) * 128 + d) * 4) = cw[tap * 1024 + ch];
        *(LAS float*)(sc + SC_WL + ((isq * 5 + 4) * 128 + d) * 4) = P.ev_cb()[jl * 1024 + ch]; }
    if (RET && tid0 < 128) { const float lg = __logf(1.0f - exp2f(-5.0f - (float)h));
#pragma unroll
        for (int p = 0; p < 2; ++p) { LAS unsigned char* s = sc + p * SC_PAR;
            *(LAS float*)(s + SC_G + 4 * tid0) = __expf(lg * (float)(127 - tid0)); *(LAS float*)(s + SC_RF + 4 * tid0) = __expf(lg * (float)(tid0 - 127));
            *(LAS float*)(s + SC_INT + 4 * tid0) = __expf(lg * (float)(tid0 + 1));
            if (tid0 == 0) { float one = 1.0f; asm volatile("" : "+v"(one)); *(LAS float*)(sc + SC_SS + 8 * p) = __expf(lg * 128.0f); *(LAS float*)(sc + SC_SS + 8 * p + 4) = one; } } }
    f32x16 Cst[2];
#pragma unroll
    for (int t = 0; t < 2; ++t)
#pragma unroll
        for (int i = 0; i < 16; ++i) Cst[t][i] = 0.f;
    v4u pk[NRAW], pq[NRAW], pv[4]; float gpre[4] = {0.f, 0.f, 0.f, 0.f};
    float m_prev = -1e30f;
    const float* GATES = (const float*)(P.ws() + WS_GATES);
#define EV_LD(ub, voff) (*(const GAS v4u*)((const GAS char*)(ub) + (size_t)(unsigned)(voff)))
#define EV_PREFETCH(cc) do { const int jg_ = tid0 >> 4, dc_ = tid0 & 15, j0_ = 4 * jg_; const unsigned voff_ = (unsigned)(j0_ * EV_N + 8 * dc_) * 2u; \
        const bf16* zu = Z + ((size_t)b * SEQ + (size_t)(cc) * CHUNK) * EV_N + h * 128;     \
        if constexpr (!RET) { _Pragma("unroll") for (int rr = 0; rr < 7; ++rr) { \
                if ((cc) == 0 && j0_ - 3 + rr < 0) { pk[rr] = (v4u){0u, 0u, 0u, 0u}; pq[rr] = (v4u){0u, 0u, 0u, 0u}; } else { pk[rr] = EV_LD(zu + (long)(rr - 3) * EV_N + COL_K, voff_); pq[rr] = EV_LD(zu + (long)(rr - 3) * EV_N + COL_Q, voff_); } } } \
        else { _Pragma("unroll") for (int jj = 0; jj < 4; ++jj) { pk[jj] = EV_LD(zu + (long)jj * EV_N + COL_K, voff_); pq[jj] = EV_LD(zu + (long)jj * EV_N + COL_Q, voff_); } } \
        _Pragma("unroll") for (int jj = 0; jj < 4; ++jj) pv[jj] = EV_LD(zu + (long)jj * EV_N + COL_V, voff_); } while (0)
#define EV_GATES_PREFETCH(cc) do { const float* gp = GATES + ((size_t)b * SEQ + (size_t)(cc) * CHUNK + 2 * (tid0 & 63)) * 8; gpre[0] = gp[h]; gpre[1] = gp[4 + h]; gpre[2] = gp[8 + h]; gpre[3] = gp[12 + h]; } while (0)
#define EV_STEP0(cc) do { const int lane_ = tid0 & 63; LAS unsigned char* sq = sc + ((cc) & 1) * SC_PAR; \
        const float ip0 = gpre[0], fp0 = gpre[1], ip1 = gpre[2], fp1 = gpre[3]; \
        const float lf0 = fminf(fp0, 0.f) - log1pf(__expf(-fabsf(fp0))), lf1 = fminf(fp1, 0.f) - log1pf(__expf(-fabsf(fp1))); \
        const float c1 = lf0 + lf1; float tot = c1; \
        _Pragma("unroll") for (int o = 1; o < 64; o <<= 1) { const float t = shup(tot, o, lane_); if (lane_ >= o) tot += t; } \
        const float ex = tot - c1, b0 = ex + lf0, b1 = ex + c1; \
        const float a0 = ip0 - b0, a1 = ip1 - b1; float pm = fmaxf(a0, a1); \
        _Pragma("unroll") for (int o = 1; o < 64; o <<= 1) { const float t = shup(pm, o, lane_); if (lane_ >= o) pm = fmaxf(pm, t); } \
        float exm = shup(pm, 1, lane_); if (lane_ == 0) exm = -3.0e38f; \
        const float mu0 = fmaxf(exm, a0), mu1 = pm; \
        const float mu127 = __builtin_bit_cast(float, __builtin_amdgcn_readlane(__builtin_bit_cast(int, pm), 63)), total = __builtin_bit_cast(float, __builtin_amdgcn_readlane(__builtin_bit_cast(int, tot), 63)); \
        const float m0 = fmaxf(b0 + mu0, b0 + m_prev), m1 = fmaxf(b1 + mu1, b1 + m_prev); \
        *(LAS f32x2v*)(sq + SC_G + 8 * lane_) = (f32x2v){__expf(a0 - mu127), __expf(a1 - mu127)}; \
        *(LAS f32x2v*)(sq + SC_RF + 8 * lane_) = (f32x2v){__expf(b0 + mu127 - m0), __expf(b1 + mu127 - m1)}; \
        *(LAS f32x2v*)(sq + SC_INT + 8 * lane_) = (f32x2v){__expf(b0 + m_prev - m0), __expf(b1 + m_prev - m1)}; \
        *(LAS f32x2v*)(sq + SC_EMM + 8 * lane_) = (f32x2v){__expf(-m0), __expf(-m1)}; \
        const float m_loc = total + mu127, m_new = fmaxf(total + m_prev, m_loc); \
        if (lane_ == 0) { *(LAS float*)(sc + SC_SS + 8 * ((cc) & 1)) = __expf(total + m_prev - m_new); *(LAS float*)(sc + SC_SS + 8 * ((cc) & 1) + 4) = __expf(m_loc - m_new); } \
        m_prev = m_new; } while (0)
    const int wv0 = __builtin_amdgcn_readfirstlane(tid0 >> 6);
    EV_PREFETCH(0);
    if (!RET && wv0 == 1) { EV_GATES_PREFETCH(0); EV_STEP0(0); EV_GATES_PREFETCH(1); }
    __syncthreads();
    for (int c = 0; c < SEQ / CHUNK; ++c) {
        int tid = tid0; asm volatile("" : "+v"(tid));
        const int lane = tid & 63, wv = __builtin_amdgcn_readfirstlane(tid >> 6), r = lane & 31, hh = lane >> 5;
        const int par = c & 1; LAS unsigned char* scp = sc + par * SC_PAR;
        const size_t rowbase = (size_t)b * SEQ + (size_t)c * CHUNK; const bf16* zc = Z + rowbase * EV_N;
        {
            const int jg = tid >> 4, dc = tid & 15, j0 = 4 * jg; float o4[4][8];
            const f32x4 gj = *(const LAS f32x4*)(scp + SC_G + 16 * jg);
            f32x4 prot[RET ? 16 : 1];
            if constexpr (RET) { const float* rp = (const float*)(P.ws() + WS_ROT) + ((size_t)(c * CHUNK + j0) * 64 + 8 * (dc & 7)) * 2;
#pragma unroll
                for (int jj = 0; jj < 4; ++jj)
#pragma unroll
                    for (int e2 = 0; e2 < 4; ++e2) prot[4 * jj + e2] = *(const GAS f32x4*)(rp + jj * 128 + 4 * e2); }
            if constexpr (!RET) conv4_silu_pre(pk, sc + SC_WL + 5 * 128 * 4, dc, o4); else rot4_pre(pk, prot, dc, lane, o4);
            float ns[8];
#pragma unroll
            for (int e = 0; e < 8; ++e) ns[e] = 0.f;
#pragma unroll
            for (int jj = 0; jj < 4; ++jj) { const float gs = KSCALE * gj[jj];
#pragma unroll
                for (int e = 0; e < 8; ++e) { o4[jj][e] *= gs; ns[e] += o4[jj][e]; }
                *(LAS v4u*)(lds + EV_K + offb(j0 + jj, dc)) = pk8(o4[jj]); }
            if constexpr (!RET) {
#pragma unroll
                for (int e = 0; e < 8; ++e) { ns[e] += sx<16>(ns[e], lane); ns[e] += sx<32>(ns[e], lane); }
                if (lane < 16) { *(LAS f32x4*)(sc + SC_NP + wv * 512 + 32 * dc) = (f32x4){ns[0], ns[1], ns[2], ns[3]}; *(LAS f32x4*)(sc + SC_NP + wv * 512 + 32 * dc + 16) = (f32x4){ns[4], ns[5], ns[6], ns[7]}; }
            }
            if constexpr (!RET) conv4_silu_pre(pq, sc + SC_WL, dc, o4); else rot4_pre(pq, prot, dc, lane, o4);
#pragma unroll
            for (int jj = 0; jj < 4; ++jj) *(LAS v4u*)(lds + EV_Q + offb(j0 + jj, dc)) = pk8(o4[jj]);
#pragma unroll
            for (int e = 0; e < 8; ++e) { unsigned short v4[4];
#pragma unroll
                for (int jj = 0; jj < 4; ++jj) v4[jj] = (unsigned short)((e & 1) ? (pv[jj][e >> 1] >> 16) : (pv[jj][e >> 1] & 0xffffu));
                u32x2 w2; w2.x = (unsigned)v4[0] | ((unsigned)v4[1] << 16); w2.y = (unsigned)v4[2] | ((unsigned)v4[3] << 16);
                *(LAS u32x2*)(lds + EV_VT + offb(8 * dc + e, jg >> 1) + 8 * (jg & 1)) = w2; }
        }
        __syncthreads();
        const int it = wv >> 1, sub = (wv & 1) * 2;
        const float s_old = *(const LAS float*)(sc + SC_SS + 8 * par), s_new = *(const LAS float*)(sc + SC_SS + 8 * par + 4);
        f32x16 Pt[2], Ot[2];
        {
            const float rfi = *(const LAS float*)(scp + SC_RF + 4 * (32 * it + r));
#pragma unroll
            for (int t = 0; t < 2; ++t) { const int jt = sub + t;
#pragma unroll
                for (int i = 0; i < 16; ++i) Pt[t][i] = 0.f;
                if (jt <= it) {
#pragma unroll
                    for (int s = 0; s < 8; ++s) { const bf16x8 a = *(const LAS bf16x8*)(lds + EV_K + offb(32 * jt + r, 2 * s + hh)), bq = *(const LAS bf16x8*)(lds + EV_Q + offb(32 * it + r, 2 * s + hh));
                        Pt[t] = __builtin_amdgcn_mfma_f32_32x32x16_bf16(a, bq, Pt[t], 0, 0, 0); }
#pragma unroll
                    for (int i = 0; i < 16; ++i) { float v = Pt[t][i] * rfi; if (jt == it && crow(i, hh) > r) v = 0.f; Pt[t][i] = v; }
                } }
        }
        if (!RET && wv == 1 && c + 1 < SEQ / CHUNK) { EV_STEP0(c + 1); if (c + 2 < SEQ / CHUNK) EV_GATES_PREFETCH(c + 2); }
        if constexpr (!RET) {
            const int i = tid >> 2, part = tid & 3; float a = 0.f;
#pragma unroll
            for (int cc = 0; cc < 4; ++cc) { float q8[8]; unpk8(*(const LAS v4u*)(lds + EV_Q + offb(i, 4 * part + cc)), q8);
                const f32x4 n0 = *(const LAS f32x4*)(sc + SC_N + 4 * (32 * part + 8 * cc)), n1 = *(const LAS f32x4*)(sc + SC_N + 4 * (32 * part + 8 * cc + 4));
                a += q8[0] * n0.x + q8[1] * n0.y + q8[2] * n0.z + q8[3] * n0.w + q8[4] * n1.x + q8[5] * n1.y + q8[6] * n1.z + q8[7] * n1.w; }
            a += sx<1>(a, lane); a += sx<2>(a, lane);
            if (part == 0) *(LAS float*)(sc + SC_QN + 4 * i) = a;
        }
        {
#pragma unroll
            for (int t = 0; t < 2; ++t) { const int dt = sub + t, vt = it; f32x16 kv;
#pragma unroll
                for (int i = 0; i < 16; ++i) kv[i] = 0.f;
#pragma unroll
                for (int s = 0; s < 8; ++s) { const bf16x8 a = tr_frag(lds + EV_K, lane, dt, s), bv = *(const LAS bf16x8*)(lds + EV_VT + offb(32 * vt + r, 2 * s + hh));
                    kv = __builtin_amdgcn_mfma_f32_32x32x16_bf16(a, bv, kv, 0, 0, 0); }
                const int vt2 = sub + t; f32x16 o;
#pragma unroll
                for (int i = 0; i < 16; ++i) o[i] = 0.f;
#pragma unroll
                for (int s = 0; s < 8; ++s) { const bf16x8 a = *(const LAS bf16x8*)(lds + EV_CT + offb(32 * vt2 + r, 2 * s + hh)), bq = *(const LAS bf16x8*)(lds + EV_Q + offb(32 * it + r, 2 * s + hh));
                    o = __builtin_amdgcn_mfma_f32_32x32x16_bf16(a, bq, o, 0, 0, 0); }
                const float inter = *(const LAS float*)(scp + SC_INT + 4 * (32 * it + r));
#pragma unroll
                for (int i = 0; i < 16; ++i) { Ot[t][i] = o[i] * inter; Cst[t][i] = s_old * Cst[t][i] + s_new * kv[i]; } }
        }
        __syncthreads();
        {
#pragma unroll
            for (int t = 0; t < 2; ++t) { const int jt = sub + t;
                if (jt <= it) {
#pragma unroll
                    for (int q = 0; q < 4; ++q) { u32x2 w2; w2.x = pk2(Pt[t][4 * q], Pt[t][4 * q + 1]); w2.y = pk2(Pt[t][4 * q + 2], Pt[t][4 * q + 3]);
                        *(LAS u32x2*)(lds + EV_K + offb(32 * it + r, 4 * jt + q) + 8 * hh) = w2; } }
                const int dt = sub + t, vt = it;
#pragma unroll
                for (int q = 0; q < 4; ++q) { u32x2 w2; w2.x = pk2(Cst[t][4 * q], Cst[t][4 * q + 1]); w2.y = pk2(Cst[t][4 * q + 2], Cst[t][4 * q + 3]);
                    *(LAS u32x2*)(lds + EV_CT + offb(32 * vt + r, 4 * dt + q) + 8 * hh) = w2; } }
            if (!RET && tid < 128) { float a = 0.f;
#pragma unroll
                for (int w = 0; w < NWAVES; ++w) a += *(const LAS float*)(sc + SC_NP + w * 512 + 4 * tid);
                LAS float* np = (LAS float*)(sc + SC_N + 4 * tid); *np = s_old * *np + s_new * a; }
        }
        __syncthreads();
        const int ei = tid >> 2, epart = tid & 3;
        const bf16* zrow = zc + (size_t)ei * EV_N + COL_G + h * 128 + 32 * epart;
        v4u og[4];
#pragma unroll
        for (int cc = 0; cc < 4; ++cc) og[cc] = *(const GAS v4u*)(zrow + 8 * cc);
        {
#pragma unroll
            for (int t = 0; t < 2; ++t) { const int vt2 = sub + t;
                for (int s = 0; s < 2 * (it + 1); ++s) { const bf16x8 a = *(const LAS bf16x8*)(lds + EV_VT + offb(32 * vt2 + r, 2 * s + hh)), bp = *(const LAS bf16x8*)(lds + EV_K + offb(32 * it + r, 2 * s + hh));
                    Ot[t] = __builtin_amdgcn_mfma_f32_32x32x16_bf16(a, bp, Ot[t], 0, 0, 0); }
#pragma unroll
                for (int q = 0; q < 4; ++q) { u32x2 w2; w2.x = pk2(Ot[t][4 * q], Ot[t][4 * q + 1]); w2.y = pk2(Ot[t][4 * q + 2], Ot[t][4 * q + 3]);
                    *(LAS u32x2*)(lds + EV_Q + offb(32 * it + r, 4 * vt2 + q) + 8 * hh) = w2; } }
        }
        __syncthreads();
        float gate[32];
#pragma unroll
        for (int cc = 0; cc < 4; ++cc) { float o8[8]; unpk8(og[cc], o8);
#pragma unroll
            for (int e = 0; e < 8; ++e) gate[8 * cc + e] = RET ? siluf_(o8[e]) : sigmoidf_(o8[e]); }
        { const int cn = c + 1 < SEQ / CHUNK ? c + 1 : c; EV_PREFETCH(cn); }
        {
            const int i = ei, part = epart; float x[32];
#pragma unroll
            for (int cc = 0; cc < 4; ++cc) { float t8[8]; unpk8(*(const LAS v4u*)(lds + EV_Q + offb(i, 4 * part + cc)), t8);
#pragma unroll
                for (int e = 0; e < 8; ++e) x[8 * cc + e] = t8[e]; }
            if constexpr (!RET) {
                float ps = 0.f;
#pragma unroll
                for (int cc = 0; cc < 4; ++cc) { float t8[8]; unpk8(*(const LAS v4u*)(lds + EV_K + offb(i, 4 * part + cc)), t8);
                    ps += ((t8[0] + t8[1]) + (t8[2] + t8[3])) + ((t8[4] + t8[5]) + (t8[6] + t8[7])); }
                ps = part <= (i >> 5) ? ps : 0.f;
                ps += sx<1>(ps, lane); ps += sx<2>(ps, lane);
                const float den = ps + *(const LAS float*)(scp + SC_INT + 4 * i) * *(const LAS float*)(sc + SC_QN + 4 * i);
                const float inv = __builtin_amdgcn_rcpf(fmaxf(fabsf(den), *(const LAS float*)(scp + SC_EMM + 4 * i)));
#pragma unroll
                for (int k = 0; k < 32; ++k) x[k] *= inv * gate[k];
            }
            float s = 0.f;
#pragma unroll
            for (int k = 0; k < 32; ++k) s += x[k];
            s += sx<1>(s, lane); s += sx<2>(s, lane);
            const float mean = s * (1.0f / 128.0f); float q = 0.f;
#pragma unroll
            for (int k = 0; k < 32; ++k) { x[k] -= mean; q += x[k] * x[k]; }
            q += sx<1>(q, lane); q += sx<2>(q, lane);
            const float rstd = __builtin_amdgcn_rsqf(q * (1.0f / 128.0f) + EPS);
            bf16* mo = (bf16*)(P.ws() + WS_MIXED) + (rowbase + i) * D + (RET ? 512 : 0) + h * 128 + 32 * part;
#pragma unroll
            for (int cc = 0; cc < 4; ++cc) { const f32x4 g0 = *(const LAS f32x4*)(sc + SC_NG + 4 * (32 * part + 8 * cc)), g1 = *(const LAS f32x4*)(sc + SC_NG + 4 * (32 * part + 8 * cc + 4)); float y[8];
                y[0] = x[8 * cc] * rstd * g0.x; y[1] = x[8 * cc + 1] * rstd * g0.y; y[2] = x[8 * cc + 2] * rstd * g0.z; y[3] = x[8 * cc + 3] * rstd * g0.w;
                y[4] = x[8 * cc + 4] * rstd * g1.x; y[5] = x[8 * cc + 5] * rstd * g1.y; y[6] = x[8 * cc + 6] * rstd * g1.z; y[7] = x[8 * cc + 7] * rstd * g1.w;
                if constexpr (RET) {
#pragma unroll
                    for (int e = 0; e < 8; ++e) y[e] *= gate[8 * cc + e]; }
                *(GAS v4u*)(mo + 8 * cc) = pk8(y); }
        }
        __syncthreads();
    }
#undef EV_PREFETCH
#undef EV_LD
#undef EV_GATES_PREFETCH
#undef EV_STEP0
}

constexpr size_t WS_NC = WS_SSQ, WS_SCAL = WS_SSQ + 524288, WS_MPREV = WS_SCAL + 8192;
struct G4 { float a, b, c, d; int h; __device__ __forceinline__ float operator[](int k) const { const int q = (k - h) >> 2; return q == 0 ? a : (q == 1 ? b : (q == 2 ? c : d)); } };
#define EV_SCALARS(FULL, gp_, mprev_, lane_, sq, mloc, tot_out) do { \
        const float ip0 = (gp_)[h], fp0 = (gp_)[4 + h], ip1 = (gp_)[8 + h], fp1 = (gp_)[12 + h]; \
        const float lf0 = fminf(fp0, 0.f) - log1pf(__expf(-fabsf(fp0))), lf1 = fminf(fp1, 0.f) - log1pf(__expf(-fabsf(fp1))); \
        const float c1 = lf0 + lf1; float csum_ = c1; \
        _Pragma("unroll") for (int o = 1; o < 64; o <<= 1) { const float t = shup(csum_, o, lane_); if (lane_ >= o) csum_ += t; } \
        const float ex = csum_ - c1, b0 = ex + lf0, b1 = ex + c1; \
        const float a0 = ip0 - b0, a1 = ip1 - b1; float pm = fmaxf(a0, a1); \
        _Pragma("unroll") for (int o = 1; o < 64; o <<= 1) { const float t = shup(pm, o, lane_); if (lane_ >= o) pm = fmaxf(pm, t); } \
        float exm = shup(pm, 1, lane_); if (lane_ == 0) exm = -3.0e38f; \
        const float mu0 = fmaxf(exm, a0), mu1 = pm; \
        const float mu127 = __builtin_bit_cast(float, __builtin_amdgcn_readlane(__builtin_bit_cast(int, pm), 63)), total = __builtin_bit_cast(float, __builtin_amdgcn_readlane(__builtin_bit_cast(int, csum_), 63)); \
        *(LAS f32x2v*)((sq) + SC_G + 8 * lane_) = (f32x2v){__expf(a0 - mu127), __expf(a1 - mu127)}; \
        if (FULL) { const float m0 = fmaxf(b0 + mu0, b0 + (mprev_)), m1 = fmaxf(b1 + mu1, b1 + (mprev_)); \
            *(LAS f32x2v*)((sq) + SC_RF + 8 * lane_) = (f32x2v){__expf(b0 + mu127 - m0), __expf(b1 + mu127 - m1)}; \
            *(LAS f32x2v*)((sq) + SC_INT + 8 * lane_) = (f32x2v){__expf(b0 + (mprev_) - m0), __expf(b1 + (mprev_) - m1)}; \
            *(LAS f32x2v*)((sq) + SC_EMM + 8 * lane_) = (f32x2v){__expf(-m0), __expf(-m1)}; } \
        mloc = total + mu127; tot_out = total; } while (0)
template <bool RET>
__device__ __forceinline__ void ev_p1_item(const Ptrs& P, int jl, LAS unsigned char* lds, int item, int tid_in) {
    int tid = tid_in; asm volatile("" : "+v"(tid));
    const bf16* Z = (const bf16*)(P.ws() + WS_Z);
    const int hi = item >> 4, c = item & 15, b = (hi >> 2) & 7, h = hi & 3;
    const int lane = tid & 63, wv = __builtin_amdgcn_readfirstlane(tid >> 6), r = lane & 31, hh = lane >> 5;
    LAS unsigned char* sc = lds + EV_SC;
    constexpr int NRAW = RET ? 4 : 7; constexpr int COL_K = RET ? 2560 : 512, COL_V = RET ? 3072 : 1024;
    const size_t rowbase = (size_t)b * SEQ + (size_t)c * CHUNK;
    const int jg = tid >> 4, dc = tid & 15, j0 = 4 * jg; const unsigned voff = (unsigned)(j0 * EV_N + 8 * dc) * 2u;
    const bf16* zu = Z + rowbase * EV_N + h * 128;
#define EV_LD(ub, vo) (*(const GAS v4u*)((const GAS char*)(ub) + (size_t)(unsigned)(vo)))
    G4 gq{0.f, 0.f, 0.f, 0.f, h};
    if constexpr (!RET) { if (wv == 0) { const float* gp = (const float*)(P.ws() + WS_GATES) + (rowbase + 2 * lane) * 8; gq.a = gp[h]; gq.b = gp[4 + h]; gq.c = gp[8 + h]; gq.d = gp[12 + h]; } }
    v4u pk[NRAW], pv[4];
    if constexpr (!RET) {
#pragma unroll
        for (int rr = 0; rr < 7; ++rr) { if (c == 0 && j0 - 3 + rr < 0) pk[rr] = (v4u){0u, 0u, 0u, 0u}; else pk[rr] = EV_LD(zu + (long)(rr - 3) * EV_N + COL_K, voff); }
    } else {
#pragma unroll
        for (int jj = 0; jj < 4; ++jj) pk[jj] = EV_LD(zu + (long)jj * EV_N + COL_K, voff);
    }
#pragma unroll
    for (int jj = 0; jj < 4; ++jj) pv[jj] = EV_LD(zu + (long)jj * EV_N + COL_V, voff);
    if constexpr (!RET) {
        if (wv == 0) { float mloc, tot; EV_SCALARS(false, gq, 0.f, lane, sc, mloc, tot);
            if (lane == 0) { float* sp = (float*)(P.ws() + WS_SCAL) + 2 * item; sp[0] = mloc; sp[1] = tot; } }
        if (tid >= 256) { const int d = tid & 127, ch = 512 + h * 128 + d; const float* cw = P.ev_cw() + (size_t)jl * 4096;
#pragma unroll
            for (int tap = 0; tap < 4; ++tap) *(LAS float*)(sc + SC_WL + ((5 + tap) * 128 + d) * 4) = cw[tap * 1024 + ch];
            *(LAS float*)(sc + SC_WL + ((5 + 4) * 128 + d) * 4) = P.ev_cb()[jl * 1024 + ch]; }
    } else if (tid < 128) { const float lg = __logf(1.0f - exp2f(-5.0f - (float)h)); *(LAS float*)(sc + SC_G + 4 * tid) = __expf(lg * (float)(127 - tid)); }
    __syncthreads();
    {
        float o4[4][8]; const f32x4 gj = *(const LAS f32x4*)(sc + SC_G + 16 * jg);
        f32x4 prot[RET ? 16 : 1];
        if constexpr (RET) { const float* rp = (const float*)(P.ws() + WS_ROT) + ((size_t)(c * CHUNK + j0) * 64 + 8 * (dc & 7)) * 2;
#pragma unroll
            for (int jj = 0; jj < 4; ++jj)
#pragma unroll
                for (int e2 = 0; e2 < 4; ++e2) prot[4 * jj + e2] = *(const GAS f32x4*)(rp + jj * 128 + 4 * e2); }
        if constexpr (!RET) conv4_silu_pre(pk, sc + SC_WL + 5 * 128 * 4, dc, o4); else rot4_pre(pk, prot, dc, lane, o4);
        float ns[8];
#pragma unroll
        for (int e = 0; e < 8; ++e) ns[e] = 0.f;
#pragma unroll
        for (int jj = 0; jj < 4; ++jj) { const float gs = KSCALE * gj[jj];
#pragma unroll
            for (int e = 0; e < 8; ++e) { o4[jj][e] *= gs; ns[e] += o4[jj][e]; }
            *(LAS v4u*)(lds + EV_K + offb(j0 + jj, dc)) = pk8(o4[jj]); }
        if constexpr (!RET) {
#pragma unroll
            for (int e = 0; e < 8; ++e) { ns[e] += sx<16>(ns[e], lane); ns[e] += sx<32>(ns[e], lane); }
            if (lane < 16) { *(LAS f32x4*)(sc + SC_NP + wv * 512 + 32 * dc) = (f32x4){ns[0], ns[1], ns[2], ns[3]}; *(LAS f32x4*)(sc + SC_NP + wv * 512 + 32 * dc + 16) = (f32x4){ns[4], ns[5], ns[6], ns[7]}; }
        }
#pragma unroll
        for (int e = 0; e < 8; ++e) { unsigned short v4[4];
#pragma unroll
            for (int jj = 0; jj < 4; ++jj) v4[jj] = (unsigned short)((e & 1) ? (pv[jj][e >> 1] >> 16) : (pv[jj][e >> 1] & 0xffffu));
            u32x2 w2; w2.x = (unsigned)v4[0] | ((unsigned)v4[1] << 16); w2.y = (unsigned)v4[2] | ((unsigned)v4[3] << 16);
            *(LAS u32x2*)(lds + EV_VT + offb(8 * dc + e, jg >> 1) + 8 * (jg & 1)) = w2; }
    }
    __syncthreads();
    {
        const int it = wv >> 1, sub = (wv & 1) * 2;
#pragma unroll
        for (int t = 0; t < 2; ++t) { const int dt = sub + t, vt = it; f32x16 kv;
#pragma unroll
            for (int i = 0; i < 16; ++i) kv[i] = 0.f;
#pragma unroll
            for (int s = 0; s < 8; ++s) { const bf16x8 a = tr_frag(lds + EV_K, lane, dt, s), bv = *(const LAS bf16x8*)(lds + EV_VT + offb(32 * vt + r, 2 * s + hh));
                kv = __builtin_amdgcn_mfma_f32_32x32x16_bf16(a, bv, kv, 0, 0, 0); }
#pragma unroll
            for (int q = 0; q < 4; ++q) { u32x2 w2; w2.x = pk2(kv[4 * q], kv[4 * q + 1]); w2.y = pk2(kv[4 * q + 2], kv[4 * q + 3]);
                *(LAS u32x2*)(lds + EV_CT + offb(32 * vt + r, 4 * dt + q) + 8 * hh) = w2; } }
        if (!RET && tid < 128) { float a = 0.f;
#pragma unroll
            for (int w = 0; w < NWAVES; ++w) a += *(const LAS float*)(sc + SC_NP + w * 512 + 4 * tid);
            ((float*)(P.ws() + WS_NC))[(size_t)item * 128 + tid] = a; }
    }
    __syncthreads();
    { unsigned char* dst = (unsigned char*)P.out() + (size_t)item * 32768 + 16 * tid;
#pragma unroll
      for (int k = 0; k < 4; ++k) *(GAS v4u*)(dst + k * 8192) = *(const LAS v4u*)(lds + EV_CT + 16 * tid + k * 8192); }
    __syncthreads();
#undef EV_LD
}
__device__ __forceinline__ void ev_p2_scan(const Ptrs& P, int gtid, int NT) {
    unsigned char* KV = (unsigned char*)P.out(); float* NC = (float*)(P.ws() + WS_NC); const float* SCAL = (const float*)(P.ws() + WS_SCAL); float* MPREV = (float*)(P.ws() + WS_MPREV);
    for (int v = gtid; v < 64 * 2048 + 32 * 128; v += NT) {
        const bool isn = v >= 64 * 2048; const int hi = isn ? (v - 64 * 2048) >> 7 : v >> 11, e = isn ? (v - 64 * 2048) & 127 : v & 2047;
        const bool ret = hi >= 32; const float gam = __expf(128.0f * __logf(1.0f - exp2f(-5.0f - (float)(hi & 3))));
        v4u xs[16]; float xn[16]; f32x2v ms[16];
#pragma unroll
        for (int c = 0; c < 16; ++c) { const int item = hi * 16 + c;
            if (isn) xn[c] = NC[(size_t)item * 128 + e]; else xs[c] = *(const GAS v4u*)(KV + (size_t)item * 32768 + 16 * e);
            ms[c] = ret ? (f32x2v){0.f, 0.f} : *(const GAS f32x2v*)(SCAL + 2 * item); }
        float C[8];
#pragma unroll
        for (int k = 0; k < 8; ++k) C[k] = 0.f;
        float m = -1e30f;
#pragma unroll
        for (int c = 0; c < 16; ++c) { const int item = hi * 16 + c; float so = gam, sn = 1.0f;
            if (!ret) { const float mloc = ms[c].x, tot = ms[c].y; const float mn = fmaxf(tot + m, mloc); so = __expf(tot + m - mn); sn = __expf(mloc - mn);
                if (!isn && e == 0) MPREV[item] = m; m = mn; }
            if (isn) { NC[(size_t)item * 128 + e] = C[0]; C[0] = so * C[0] + sn * xn[c]; }
            else { float x[8]; unpk8(xs[c], x); *(GAS v4u*)(KV + (size_t)item * 32768 + 16 * e) = pk8(C);
#pragma unroll
                for (int k = 0; k < 8; ++k) C[k] = so * C[k] + sn * x[k]; } }
    }
}
template <bool RET>
__device__ __forceinline__ void ev_p3_item(const Ptrs& P, int jl, LAS unsigned char* lds, int item, int tid_in) {
    int tid = tid_in; asm volatile("" : "+v"(tid));
    const bf16* Z = (const bf16*)(P.ws() + WS_Z);
    const int hi = item >> 4, c = item & 15, b = (hi >> 2) & 7, h = hi & 3;
    const int lane = tid & 63, wv = __builtin_amdgcn_readfirstlane(tid >> 6), r = lane & 31, hh = lane >> 5;
    LAS unsigned char* sc = lds + EV_SC; LAS unsigned char* scp = sc;
    constexpr int NRAW = RET ? 4 : 7; constexpr int COL_K = RET ? 2560 : 512, COL_Q = RET ? 2048 : 0, COL_V = RET ? 3072 : 1024, COL_G = RET ? 3584 : 1536;
    const size_t rowbase = (size_t)b * SEQ + (size_t)c * CHUNK; const bf16* zc = Z + rowbase * EV_N;
    const int jg = tid >> 4, dc = tid & 15, j0 = 4 * jg; const unsigned voff = (unsigned)(j0 * EV_N + 8 * dc) * 2u;
    const bf16* zu = zc + h * 128;
#define EV_LD(ub, vo) (*(const GAS v4u*)((const GAS char*)(ub) + (size_t)(unsigned)(vo)))
    G4 gq{0.f, 0.f, 0.f, 0.f, h}; float mp = 0.f, npv = 0.f;
    if constexpr (!RET) {
        if (wv == 0) { const float* gp = (const float*)(P.ws() + WS_GATES) + (rowbase + 2 * lane) * 8; gq.a = gp[h]; gq.b = gp[4 + h]; gq.c = gp[8 + h]; gq.d = gp[12 + h]; mp = ((const float*)(P.ws() + WS_MPREV))[item]; }
        if (wv >= 2 && wv < 4) npv = ((const float*)(P.ws() + WS_NC))[(size_t)item * 128 + (tid - 128)];
    }
    v4u pk[NRAW], pq[NRAW], pv[4], cti[4];
    if constexpr (!RET) {
#pragma unroll
        for (int rr = 0; rr < 7; ++rr) { if (c == 0 && j0 - 3 + rr < 0) { pk[rr] = (v4u){0u, 0u, 0u, 0u}; pq[rr] = (v4u){0u, 0u, 0u, 0u}; } else { pk[rr] = EV_LD(zu + (long)(rr - 3) * EV_N + COL_K, voff); pq[rr] = EV_LD(zu + (long)(rr - 3) * EV_N + COL_Q, voff); } }
    } else {
#pragma unroll
        for (int jj = 0; jj < 4; ++jj) { pk[jj] = EV_LD(zu + (long)jj * EV_N + COL_K, voff); pq[jj] = EV_LD(zu + (long)jj * EV_N + COL_Q, voff); }
    }
#pragma unroll
    for (int jj = 0; jj < 4; ++jj) pv[jj] = EV_LD(zu + (long)jj * EV_N + COL_V, voff);
    { const unsigned char* src = (unsigned char*)P.out() + (size_t)item * 32768 + 16 * tid;
#pragma unroll
      for (int k = 0; k < 4; ++k) cti[k] = *(const GAS v4u*)(src + k * 8192); }
    if (tid < 128) *(LAS float*)(sc + SC_NG + 4 * tid) = (RET ? P.ev_ngr() : P.ev_ngm())[jl * 512 + h * 128 + tid];
    if constexpr (!RET) {
        if (wv == 0) { float mloc, tot; EV_SCALARS(true, gq, mp, lane, sc, mloc, tot); (void)mloc; (void)tot; }
        if (wv >= 2 && wv < 4) *(LAS float*)(sc + SC_N + 4 * (tid - 128)) = npv;
        if (tid >= 256) { const int isq = (tid - 256) >> 7, d = tid & 127, ch = (isq ? 512 : 0) + h * 128 + d; const float* cw = P.ev_cw() + (size_t)jl * 4096;
#pragma unroll
            for (int tap = 0; tap < 4; ++tap) *(LAS float*)(sc + SC_WL + ((isq * 5 + tap) * 128 + d) * 4) = cw[tap * 1024 + ch];
            *(LAS float*)(sc + SC_WL + ((isq * 5 + 4) * 128 + d) * 4) = P.ev_cb()[jl * 1024 + ch]; }
    } else if (tid < 128) { const float lg = __logf(1.0f - exp2f(-5.0f - (float)h));
        *(LAS float*)(sc + SC_G + 4 * tid) = __expf(lg * (float)(127 - tid)); *(LAS float*)(sc + SC_RF + 4 * tid) = __expf(lg * (float)(tid - 127)); *(LAS float*)(sc + SC_INT + 4 * tid) = __expf(lg * (float)(tid + 1)); }
    __syncthreads();
    {
        float o4[4][8]; const f32x4 gj = *(const LAS f32x4*)(scp + SC_G + 16 * jg);
        f32x4 prot[RET ? 16 : 1];
        if constexpr (RET) { const float* rp = (const float*)(P.ws() + WS_ROT) + ((size_t)(c * CHUNK + j0) * 64 + 8 * (dc & 7)) * 2;
#pragma unroll
            for (int jj = 0; jj < 4; ++jj)
#pragma unroll
                for (int e2 = 0; e2 < 4; ++e2) prot[4 * jj + e2] = *(const GAS f32x4*)(rp + jj * 128 + 4 * e2); }
        if constexpr (!RET) conv4_silu_pre(pk, sc + SC_WL + 5 * 128 * 4, dc, o4); else rot4_pre(pk, prot, dc, lane, o4);
#pragma unroll
        for (int jj = 0; jj < 4; ++jj) { const float gs = KSCALE * gj[jj];
#pragma unroll
            for (int e = 0; e < 8; ++e) o4[jj][e] *= gs;
            *(LAS v4u*)(lds + EV_K + offb(j0 + jj, dc)) = pk8(o4[jj]); }
        if constexpr (!RET) conv4_silu_pre(pq, sc + SC_WL, dc, o4); else rot4_pre(pq, prot, dc, lane, o4);
#pragma unroll
        for (int jj = 0; jj < 4; ++jj) *(LAS v4u*)(lds + EV_Q + offb(j0 + jj, dc)) = pk8(o4[jj]);
#pragma unroll
        for (int e = 0; e < 8; ++e) { unsigned short v4[4];
#pragma unroll
            for (int jj = 0; jj < 4; ++jj) v4[jj] = (unsigned short)((e & 1) ? (pv[jj][e >> 1] >> 16) : (pv[jj][e >> 1] & 0xffffu));
            u32x2 w2; w2.x = (unsigned)v4[0] | ((unsigned)v4[1] << 16); w2.y = (unsigned)v4[2] | ((unsigned)v4[3] << 16);
            *(LAS u32x2*)(lds + EV_VT + offb(8 * dc + e, jg >> 1) + 8 * (jg & 1)) = w2; }
#pragma unroll
        for (int k = 0; k < 4; ++k) *(LAS v4u*)(lds + EV_CT + 16 * tid + k * 8192) = cti[k];
    }
    __syncthreads();
    const int it = wv >> 1, sub = (wv & 1) * 2;
    f32x16 Pt[2], Ot[2];
    {
        const float rfi = *(const LAS float*)(scp + SC_RF + 4 * (32 * it + r));
#pragma unroll
        for (int t = 0; t < 2; ++t) { const int jt = sub + t;
#pragma unroll
            for (int i = 0; i < 16; ++i) Pt[t][i] = 0.f;
            if (jt <= it) {
#pragma unroll
                for (int s = 0; s < 8; ++s) { const bf16x8 a = *(const LAS bf16x8*)(lds + EV_K + offb(32 * jt + r, 2 * s + hh)), bq = *(const LAS bf16x8*)(lds + EV_Q + offb(32 * it + r, 2 * s + hh));
                    Pt[t] = __builtin_amdgcn_mfma_f32_32x32x16_bf16(a, bq, Pt[t], 0, 0, 0); }
#pragma unroll
                for (int i = 0; i < 16; ++i) { float v = Pt[t][i] * rfi; if (jt == it && crow(i, hh) > r) v = 0.f; Pt[t][i] = v; }
            } }
    }
    if constexpr (!RET) {
        const int i = tid >> 2, part = tid & 3; float a = 0.f;
#pragma unroll
        for (int cc = 0; cc < 4; ++cc) { float q8[8]; unpk8(*(const LAS v4u*)(lds + EV_Q + offb(i, 4 * part + cc)), q8);
            const f32x4 n0 = *(const LAS f32x4*)(sc + SC_N + 4 * (32 * part + 8 * cc)), n1 = *(const LAS f32x4*)(sc + SC_N + 4 * (32 * part + 8 * cc + 4));
            a += q8[0] * n0.x + q8[1] * n0.y + q8[2] * n0.z + q8[3] * n0.w + q8[4] * n1.x + q8[5] * n1.y + q8[6] * n1.z + q8[7] * n1.w; }
        a += sx<1>(a, lane); a += sx<2>(a, lane);
        if (part == 0) *(LAS float*)(sc + SC_QN + 4 * i) = a;
    }
    {
        const float inter = *(const LAS float*)(scp + SC_INT + 4 * (32 * it + r));
#pragma unroll
        for (int t = 0; t < 2; ++t) { const int vt2 = sub + t; f32x16 o;
#pragma unroll
            for (int i = 0; i < 16; ++i) o[i] = 0.f;
#pragma unroll
            for (int s = 0; s < 8; ++s) { const bf16x8 a = *(const LAS bf16x8*)(lds + EV_CT + offb(32 * vt2 + r, 2 * s + hh)), bq = *(const LAS bf16x8*)(lds + EV_Q + offb(32 * it + r, 2 * s + hh));
                o = __builtin_amdgcn_mfma_f32_32x32x16_bf16(a, bq, o, 0, 0, 0); }
#pragma unroll
            for (int i = 0; i < 16; ++i) Ot[t][i] = o[i] * inter; }
    }
    __syncthreads();
#pragma unroll
    for (int t = 0; t < 2; ++t) { const int jt = sub + t;
        if (jt <= it) {
#pragma unroll
            for (int q = 0; q < 4; ++q) { u32x2 w2; w2.x = pk2(Pt[t][4 * q], Pt[t][4 * q + 1]); w2.y = pk2(Pt[t][4 * q + 2], Pt[t][4 * q + 3]);
                *(LAS u32x2*)(lds + EV_K + offb(32 * it + r, 4 * jt + q) + 8 * hh) = w2; } } }
    __syncthreads();
    const int ei = tid >> 2, epart = tid & 3;
    const bf16* zrow = zc + (size_t)ei * EV_N + COL_G + h * 128 + 32 * epart;
    v4u og[4];
#pragma unroll
    for (int cc = 0; cc < 4; ++cc) og[cc] = *(const GAS v4u*)(zrow + 8 * cc);
#pragma unroll
    for (int t = 0; t < 2; ++t) { const int vt2 = sub + t;
        for (int s = 0; s < 2 * (it + 1); ++s) { const bf16x8 a = *(const LAS bf16x8*)(lds + EV_VT + offb(32 * vt2 + r, 2 * s + hh)), bp = *(const LAS bf16x8*)(lds + EV_K + offb(32 * it + r, 2 * s + hh));
            Ot[t] = __builtin_amdgcn_mfma_f32_32x32x16_bf16(a, bp, Ot[t], 0, 0, 0); }
#pragma unroll
        for (int q = 0; q < 4; ++q) { u32x2 w2; w2.x = pk2(Ot[t][4 * q], Ot[t][4 * q + 1]); w2.y = pk2(Ot[t][4 * q + 2], Ot[t][4 * q + 3]);
            *(LAS u32x2*)(lds + EV_Q + offb(32 * it + r, 4 * vt2 + q) + 8 * hh) = w2; } }
    __syncthreads();
    {
        float gate[32];
#pragma unroll
        for (int cc = 0; cc < 4; ++cc) { float o8[8]; unpk8(og[cc], o8);
#pragma unroll
            for (int e = 0; e < 8; ++e) gate[8 * cc + e] = RET ? siluf_(o8[e]) : sigmoidf_(o8[e]); }
        const int i = ei, part = epart; float x[32];
#pragma unroll
        for (int cc = 0; cc < 4; ++cc) { float t8[8]; unpk8(*(const LAS v4u*)(lds + EV_Q + offb(i, 4 * part + cc)), t8);
#pragma unroll
            for (int e = 0; e < 8; ++e) x[8 * cc + e] = t8[e]; }
        if constexpr (!RET) {
            float ps = 0.f;
#pragma unroll
            for (int cc = 0; cc < 4; ++cc) { float t8[8]; unpk8(*(const LAS v4u*)(lds + EV_K + offb(i, 4 * part + cc)), t8);
                ps += ((t8[0] + t8[1]) + (t8[2] + t8[3])) + ((t8[4] + t8[5]) + (t8[6] + t8[7])); }
            ps = part <= (i >> 5) ? ps : 0.f;
            ps += sx<1>(ps, lane); ps += sx<2>(ps, lane);
            const float den = ps + *(const LAS float*)(scp + SC_INT + 4 * i) * *(const LAS float*)(sc + SC_QN + 4 * i);
            const float inv = __builtin_amdgcn_rcpf(fmaxf(fabsf(den), *(const LAS float*)(scp + SC_EMM + 4 * i)));
#pragma unroll
            for (int k = 0; k < 32; ++k) x[k] *= inv * gate[k];
        }
        float s = 0.f;
#pragma unroll
        for (int k = 0; k < 32; ++k) s += x[k];
        s += sx<1>(s, lane); s += sx<2>(s, lane);
        const float mean = s * (1.0f / 128.0f); float q = 0.f;
#pragma unroll
        for (int k = 0; k < 32; ++k) { x[k] -= mean; q += x[k] * x[k]; }
        q += sx<1>(q, lane); q += sx<2>(q, lane);
        const float rstd = __builtin_amdgcn_rsqf(q * (1.0f / 128.0f) + EPS);
        bf16* mo = (bf16*)(P.ws() + WS_MIXED) + (rowbase + i) * D + (RET ? 512 : 0) + h * 128 + 32 * part;
#pragma unroll
        for (int cc = 0; cc < 4; ++cc) { const f32x4 g0 = *(const LAS f32x4*)(sc + SC_NG + 4 * (32 * part + 8 * cc)), g1 = *(const LAS f32x4*)(sc + SC_NG + 4 * (32 * part + 8 * cc + 4)); float y[8];
            y[0] = x[8 * cc] * rstd * g0.x; y[1] = x[8 * cc + 1] * rstd * g0.y; y[2] = x[8 * cc + 2] * rstd * g0.z; y[3] = x[8 * cc + 3] * rstd * g0.w;
            y[4] = x[8 * cc + 4] * rstd * g1.x; y[5] = x[8 * cc + 5] * rstd * g1.y; y[6] = x[8 * cc + 6] * rstd * g1.z; y[7] = x[8 * cc + 7] * rstd * g1.w;
            if constexpr (RET) {
#pragma unroll
                for (int e = 0; e < 8; ++e) y[e] *= gate[8 * cc + e]; }
            *(GAS v4u*)(mo + 8 * cc) = pk8(y); }
    }
    __syncthreads();
#undef EV_LD
}

struct Args { const float* in[23]; float* out; unsigned char* ws; int ph_lo, ph_hi; };
constexpr int N_PHASES = 2 + 8 * ((DEPTH + 1) / 2) + 6 * (DEPTH / 2);
#ifndef RPT_P1
#define RPT_P1 1
#endif
#ifndef RPT_P3
#define RPT_P3 1
#endif
#ifndef RPT_M
#define RPT_M 1
#endif
#ifndef RPT_R
#define RPT_R 1
#endif
#ifndef RPT_CV
#define RPT_CV 1
#endif
#ifndef RPT_WIN
#define RPT_WIN 1
#endif
#ifndef RPT_MIX
#define RPT_MIX 1
#endif
#ifndef RPT_GU
#define RPT_GU 1
#endif
#ifndef MK_ONE_LAUNCH
#define MK_ONE_LAUNCH 1
#endif
__global__ void __launch_bounds__(NWAVES * 64, 2) mk_fwd(Args args) {
    extern __shared__ __attribute__((aligned(16))) unsigned char lds_raw[];
    LAS unsigned char* lds = (LAS unsigned char*)lds_raw;
    volatile LAS unsigned* MISC = (volatile LAS unsigned*)(lds + MISC_OFF);
    const int wave_s = __builtin_amdgcn_readfirstlane((int)threadIdx.x >> 6);
#define HWTID() (wave_s * 64 + hw_lane())
    const int G = gridDim.x, bx = blockIdx.x;
    const int vcu = (G % 8 == 0) ? (bx % 8) * (G / 8) + bx / 8 : bx;
    const int NGW = G * NWAVES;
#define GW (vcu * NWAVES + wave)
    const Ptrs P;
    gu32* ctl = (gu32*)(P.ws() + WS_CTL);
    for (int u = HWTID(); u < (LDS_BYTES - LDSCTL_OFF) / 4; u += NWAVES * 64) ((LAS unsigned*)(lds + LDSCTL_OFF))[u] = 0u;
    __syncthreads();
    const int lo = P.ph_lo(), hi = P.ph_hi();
    const bool use_bar = (hi - lo) > 1;
    XcdBarrier bar; bar.bar = (unsigned*)(ctl + CW_BAR); bar.x = 0; bar.st = nullptr;
    if (use_bar) bar = xcd_barrier_post((unsigned*)(ctl + CW_BAR), MISC + 8, HWTID());
#define IN(k) (lo <= (k) && (k) < hi)
#define FRESH() int tid = HWTID(); asm volatile("" : "+v"(tid)); const int lane = tid & 63, wave = __builtin_amdgcn_readfirstlane(tid >> 6); (void)lane; (void)wave
#define TAIL_CV(nwg_, body_) do { const int rem_ = (nwg_) % G; if (rem_ == 0 || bx >= rem_) { FRESH(); const int wk = (rem_ ? bx - rem_ : bx) * NWAVES + wave, NWK = (rem_ ? G - rem_ : G) * NWAVES; \
        LAS float* scr = (LAS float*)(lds + RING_OFF + wave * 16384); (void)lane; body_; } } while (0)
#define SEAM(k) do { if (IN(k) && IN((k) + 1)) xcd_barrier(bar, HWTID()); } while (0)

#define XB ((bf16*)(P.ws() + WS_XB))
#define MIXED ((bf16*)(P.ws() + WS_MIXED))
#define ZB ((bf16*)(P.ws() + WS_Z))
#define ACT ((bf16*)(P.ws() + WS_Z))
#define SSQ ((float*)(P.ws() + WS_SSQ))
    if (IN(0)) { FRESH(); LAS float* scr = (LAS float*)(lds + RING_OFF + wave * 16384); prologue_rows(P, GW, NGW, lane); cv_in(P, 0, scr, GW, NGW, lane); cv_out(P, 0, scr, GW, NGW, lane); }
    SEAM(0);
    int pbase = 0;
    for (int L = 0; L < DEPTH; ++L) {
        const int j = L >> 1; const bool even = (L & 1) == 0;
        const int p_in = pbase + 1, p_mix = pbase + 2, p_out = pbase + (even ? 5 : 3), p_q = p_out + 1, p_gu = p_out + 2, p_dn = p_out + 3; pbase = p_dn;
        if (IN(p_in)) for (int rp = 0; rp < RPT_WIN; ++rp) {
            if (rp) xcd_barrier(bar, HWTID());
            const int N = even ? EV_N : OD_N;
            pg8::Gemm g{XB, (const bf16*)(P.ws() + (even ? WS_WIN_A : WS_WIN_B)), M, N, D}; pg8::StaticOrder S; S.init(M, N, G, bx);
            pg8::EpiZ E{ZB, N, SSQ};
            pg8::gemm_phase<pg8::EpiZ, pg8::StaticOrder, true, true>(lds + RING_OFF, g, S, E, HWTID());
            if (even) { FRESH(); gates_rows(P, j, GW, NGW, lane); }
            else if (L == 1) { TAIL_CV((M / 256) * (OD_N / 256), cv_ffn(P, 2, lds, scr, wk, NWK, lane)); }
        }
        SEAM(p_in);
        if (even) {
            if (IN(p_mix)) for (int rp = 0; rp < RPT_P1; ++rp) { if (rp) xcd_barrier(bar, HWTID()); FRESH();
                for (int it = bx; it < 1024; it += G) { if ((it >> 4) >= 32) ev_p1_item<true>(P, j, lds, it, tid); else ev_p1_item<false>(P, j, lds, it, tid); }
                LAS float* scr = (LAS float*)(lds + RING_OFF + wave * 16384);
                if (L == 0) cv_ffn(P, 0, lds, scr, GW, NGW, lane); }
            SEAM(p_mix);
            if (IN(p_mix + 1)) { FRESH(); ev_p2_scan(P, (bx * NWAVES + wave) * 64 + lane, G * NWAVES * 64); }
            SEAM(p_mix + 1);
            if (IN(p_mix + 2)) for (int rp = 0; rp < RPT_P3; ++rp) { if (rp) xcd_barrier(bar, HWTID()); FRESH();
                for (int it = bx; it < 1024; it += G) { if ((it >> 4) >= 32) ev_p3_item<true>(P, j, lds, it, tid); else ev_p3_item<false>(P, j, lds, it, tid); } }
            SEAM(p_mix + 2);
        } else {
            if (IN(p_mix)) { FRESH(); for (int it = bx; it < M / 64; it += G) od_fast_item(P, j, lds, it, tid); }
            SEAM(p_mix);
        }
        if (IN(p_out)) {
            pg8::Gemm g{MIXED, (const bf16*)(P.ws() + WS_WOUT) + (size_t)L * D * D, M, D, D}; pg8::StaticOrder S; S.init(M, D, G, bx);
            pg8::EpiRes E{XB, SSQ, D};
            pg8::gemm_phase<pg8::EpiRes, pg8::StaticOrder, true, true>(lds + RING_OFF, g, S, E, HWTID());
        }
        SEAM(p_out);
        if (IN(p_q)) { FRESH(); quant_rows(P, GW, NGW, lane); }
        SEAM(p_q);
        if (IN(p_gu)) for (int rp = 0; rp < RPT_GU; ++rp) {
            if (rp) xcd_barrier(bar, HWTID());
            pg8::Gemm g{(const bf16*)(P.ws() + WS_XQ), (const bf16*)(P.ws() + (even ? WS_WGU_A : WS_WGU_B)), M, NGU, D / 2}; pg8::StaticOrder S; S.init(M, NGU, G, bx);
            pg8::EpiSwiGLUq E{ACT, DFF, (const float*)(P.ws() + WS_RSQ), (const float*)(P.ws() + (even ? WS_WGU_A : WS_WGU_B) + WGU_CS_OFF)};
            pg8::gemm_phase<pg8::EpiSwiGLUq, pg8::StaticOrder, true, true, true>(lds + RING_OFF, g, S, E, HWTID());
            if (L == 0) { TAIL_CV((M / 256) * (NGU / 256), (cv_in(P, 1, scr, wk, NWK, lane), cv_out(P, 1, scr, wk, NWK, lane), cv_ffn(P, 1, lds, scr, wk, NWK, lane))); }
            else if (L == 1) { TAIL_CV((M / 256) * (NGU / 256), (cv_in(P, 2, scr, wk, NWK, lane), cv_out(P, 2, scr, wk, NWK, lane), cv_in(P, 3, scr, wk, NWK, lane), cv_out(P, 3, scr, wk, NWK, lane))); }
            else if (L == 2) { TAIL_CV((M / 256) * (NGU / 256), cv_ffn(P, 3, lds, scr, wk, NWK, lane)); }
        }
        SEAM(p_gu);
        if (IN(p_dn)) {
            pg8::Gemm g{ACT, (const bf16*)(P.ws() + (even ? WS_WD_A : WS_WD_B)), M, D, DFF}; pg8::StaticOrder S; S.init(M, D, G, bx);
            pg8::EpiRes E{XB, SSQ, D};
            pg8::gemm_phase<pg8::EpiRes, pg8::StaticOrder, true, true>(lds + RING_OFF, g, S, E, HWTID());
        }
        SEAM(p_dn);
    }
    if (IN(N_PHASES - 1)) { FRESH(); final_norm(P, GW, NGW, lane); }
#undef IN
#undef SEAM
#undef TAIL_CV
#undef FRESH
#undef HWTID
#undef GW
#undef XB
#undef MIXED
#undef ZB
#undef ACT
#undef SSQ
}

extern "C" void kernel_launch(void* const* d_in, const int* in_sizes, int n_in, void* d_out, int out_size, void* d_ws, size_t ws_size, hipStream_t stream) {
    static int grid = 0;
    if (grid == 0) {
        if (n_in != 23 || in_sizes[0] != M * D || out_size != M * D || ws_size < WS_END) { fprintf(stderr, "kernel_launch: unexpected shapes (n_in %d, in0 %d, out %d, ws %zu)\n", n_in, n_in > 0 ? in_sizes[0] : -1, out_size, ws_size); grid = -1; return; }
        int dev = 0, cus = 0, per_cu = 0;
        if (hipGetDevice(&dev) != hipSuccess || hipDeviceGetAttribute(&cus, hipDeviceAttributeMultiprocessorCount, dev) != hipSuccess) { grid = -1; return; }
        if (hipFuncSetAttribute((const void*)mk_fwd, hipFuncAttributeMaxDynamicSharedMemorySize, LDS_BYTES) != hipSuccess) { fprintf(stderr, "kernel_launch: hipFuncSetAttribute failed\n"); grid = -1; return; }
        if (hipOccupancyMaxActiveBlocksPerMultiprocessor(&per_cu, (const void*)mk_fwd, NWAVES * 64, LDS_BYTES) != hipSuccess || per_cu < 1) { fprintf(stderr, "kernel_launch: occupancy query reports %d blocks per CU\n", per_cu); per_cu = 1; }
        (void)hipGetLastError();
        grid = cus;
        if (grid > 256) grid = 256;
    }
    if (grid < 0) return;
    (void)hipMemsetAsync((char*)d_ws + WS_CTL, 0, CTL_ZERO_BYTES, stream);
    Args a{};
    for (int i = 0; i < 23; ++i) a.in[i] = (const float*)d_in[i];
    a.out = (float*)d_out; a.ws = (unsigned char*)d_ws;
#if MK_ONE_LAUNCH
    a.ph_lo = 0; a.ph_hi = N_PHASES;
    hipLaunchKernelGGL(mk_fwd, dim3(grid), dim3(NWAVES * 64), LDS_BYTES, stream, a);
#else
    for (int ph = 0; ph < N_PHASES; ++ph) { a.ph_lo = ph; a.ph_hi = ph + 1; hipLaunchKernelGGL(mk_fwd, dim3(grid), dim3(NWAVES * 64), LDS_BYTES, stream, a); }
#endif
}
```
